# Optimizing an MI355X kernel written in HIP

```python
import math
import jax, jax.numpy as jnp
from jax import lax
import numpy as np

D_MODEL = 2048
BATCH = 4
SEQ = 4096
DEPTH = 4

GRID_W = 64
CTX_LEN = 256
HEAD_DIM = 128
W_GDN = D_MODEL // 4
W_GQA = D_MODEL // 2
W_LRU = D_MODEL - W_GDN - W_GQA
GDN_HEADS = W_GDN // HEAD_DIM
GDN_CHUNK = 64
GDN_CONV = 4
GQA_Q_HEADS = W_GQA // HEAD_DIM
GQA_KV_HEADS = GQA_Q_HEADS // 4
Q_BLOCK = 128
ROPE_THETA = 10000.0
LRU_BLOCKS = 8
LRU_BLOCK = W_LRU // LRU_BLOCKS
LRU_CONV = 4
LRU_C = 8.0
FFN_DIM = ((8 * D_MODEL // 3 + 127) // 128) * 128
FFN_CONV = 3
N_MOD = 6
EPS = 1e-6
IN_SPLITS = (3 * W_GDN, W_GDN, GDN_HEADS, GDN_HEADS, GDN_HEADS, GDN_HEADS,
             W_GQA, GQA_KV_HEADS * HEAD_DIM, GQA_KV_HEADS * HEAD_DIM, W_LRU, W_LRU)
IN_COLS = 4 * W_GDN + 4 * GDN_HEADS + W_GQA + 2 * GQA_KV_HEADS * HEAD_DIM + 2 * W_LRU

kernel_name = 'hybrid_parallel_heads_flow_block'


def rmsnorm(x, g):
    xf = x.astype(jnp.float32)
    y = xf * lax.rsqrt(jnp.mean(xf * xf, axis=-1, keepdims=True) + EPS)
    return y.astype(x.dtype) * g


def l2norm(x):
    xf = x.astype(jnp.float32)
    return (xf * lax.rsqrt(jnp.sum(xf * xf, axis=-1, keepdims=True) + EPS)).astype(x.dtype)


def modulate(h, shift, scale):
    return h * (1 + scale) + shift


def adaln(cond, w, b):
    return jax.nn.silu(cond) @ w + b


def depthwise_conv(x, w, pad_left):
    width, t = w.shape[0], x.shape[1]
    xp = jnp.pad(x, ((0, 0), (pad_left, width - 1 - pad_left), (0, 0)))
    y = xp[:, 0:t] * w[0]
    for j in range(1, width):
        y = y + xp[:, j:j + t] * w[j]
    return y


def identity(t):
    return t


def reverse(t):
    return jnp.flip(t, axis=1)


def split_columns(p):
    bounds, acc = [], 0
    for s in IN_SPLITS[:-1]:
        acc += s
        bounds.append(acc)
    return jnp.split(p, bounds, axis=-1)


def axial_rope_tables(n_tokens):
    rows = n_tokens // GRID_W
    row = jnp.repeat(jnp.arange(rows, dtype=jnp.float32), GRID_W)
    col = jnp.tile(jnp.arange(GRID_W, dtype=jnp.float32), rows)
    axis_dim = HEAD_DIM // 2
    inv_freq = ROPE_THETA ** (-jnp.arange(0, axis_dim, 2, dtype=jnp.float32) / axis_dim)
    ang = jnp.concatenate([row[:, None] * inv_freq, col[:, None] * inv_freq], axis=-1)
    return jnp.cos(ang), jnp.sin(ang)


def apply_axial_rope(x, cos, sin):
    b, t, h, d = x.shape
    xr = x.reshape(b, t, h, 2, 2, d // 4)
    x1, x2 = xr[..., 0, :], xr[..., 1, :]
    c = cos.reshape(t, 1, 2, d // 4)
    s = sin.reshape(t, 1, 2, d // 4)
    out = jnp.stack([x1 * c - x2 * s, x2 * c + x1 * s], axis=-2)
    return out.reshape(b, t, h, d).astype(x.dtype)


def gated_delta_chunked(q, k, v, log_a, beta, s0):
    b, t, h, dk = q.shape
    dv = v.shape[-1]
    n = t // GDN_CHUNK

    def chunks(z):
        z = z.astype(jnp.float32).reshape(b, n, GDN_CHUNK, h, *z.shape[3:])
        return jnp.moveaxis(z, (1, 3), (0, 2))

    qc, kc, vc = chunks(q), chunks(k), chunks(v)
    la, bt = chunks(log_a), chunks(beta)
    g = jnp.cumsum(la, axis=-1)
    idx = jnp.arange(GDN_CHUNK)
    incl = idx[:, None] >= idx[None, :]
    strict = idx[:, None] > idx[None, :]
    dmask = jnp.exp(jnp.where(incl, g[..., :, None] - g[..., None, :], -jnp.inf))
    kb = kc * bt[..., None]
    lower = jnp.einsum('nbhcd,nbhsd->nbhcs', kb, kc) * jnp.where(strict, dmask, 0.0)
    lhs = lower + jnp.eye(GDN_CHUNK, dtype=jnp.float32)
    rhs = jnp.concatenate([vc * bt[..., None], kb * jnp.exp(g)[..., None]], axis=-1)
    sol = lax.linalg.triangular_solve(lhs, rhs, left_side=True, lower=True, unit_diagonal=True)
    u, w = sol[..., :dv], sol[..., dv:]
    attn = jnp.einsum('nbhcd,nbhsd->nbhcs', qc, kc) * dmask
    q_dec = qc * jnp.exp(g)[..., None]
    g_last = g[..., -1]
    k_dec = kc * jnp.exp(g_last[..., None] - g)[..., None]

    def step(s, xs):
        u_i, w_i, q_i, a_i, k_i, gl_i = xs
        v_new = u_i - jnp.einsum('bhcd,bhde->bhce', w_i, s)
        o_i = jnp.einsum('bhcd,bhde->bhce', q_i, s) + jnp.einsum('bhcs,bhse->bhce', a_i, v_new)
        s = s * jnp.exp(gl_i)[..., None, None] + jnp.einsum('bhcd,bhce->bhde', k_i, v_new)
        return s, o_i

    s_final, o = lax.scan(step, s0.astype(jnp.float32), (u, w, q_dec, attn, k_dec, g_last))
    o = jnp.moveaxis(o, (0, 2), (1, 3)).reshape(b, t, h, dv)
    return o.astype(v.dtype), s_final


def gdn_stream(parts, conv_w, a_log, dt_bias):
    qkv, z, b_f, b_b, a_f, a_b = parts
    b, t, _ = qkv.shape
    qkv = jax.nn.silu(depthwise_conv(qkv, conv_w, GDN_CONV // 2))
    q, k, v = jnp.split(qkv, 3, axis=-1)
    q = l2norm(q.reshape(b, t, GDN_HEADS, HEAD_DIM)) * (HEAD_DIM ** -0.5)
    k = l2norm(k.reshape(b, t, GDN_HEADS, HEAD_DIM))
    v = v.reshape(b, t, GDN_HEADS, HEAD_DIM)
    a_log = a_log.astype(jnp.float32)
    dt_bias = dt_bias.astype(jnp.float32)
    dirs = []
    for d, (a_raw, b_raw) in enumerate(((a_f, b_f), (a_b, b_b))):
        log_a = -jnp.exp(a_log[d]) * jax.nn.softplus(a_raw.astype(jnp.float32) + dt_bias[d])
        dirs.append((log_a, jax.nn.sigmoid(b_raw.astype(jnp.float32))))
    return q, k, v, z, dirs


def gated_rmsnorm(o, z, g):
    b, t, h, dv = o.shape
    y = rmsnorm(o, g) * jax.nn.silu(z.reshape(b, t, h, dv))
    return y.reshape(b, t, h * dv)


def gdn_mixer(parts_l, parts_c, conv_w, a_log, dt_bias, norm_g, ctx_out):
    ql, kl, vl, zl, dl = gdn_stream(parts_l, conv_w, a_log, dt_bias)
    qc, kc, vc, zc, dc = gdn_stream(parts_c, conv_w, a_log, dt_bias)
    s0 = jnp.zeros((qc.shape[0], GDN_HEADS, HEAD_DIM, HEAD_DIM), jnp.float32)
    outs_l, outs_c = [], []
    for d, f in enumerate((identity, reverse)):
        (la_c, bt_c), (la_l, bt_l) = dc[d], dl[d]
        oc, sc = gated_delta_chunked(f(qc), f(kc), f(vc), f(la_c), f(bt_c), s0)
        ol, _ = gated_delta_chunked(f(ql), f(kl), f(vl), f(la_l), f(bt_l), sc)
        outs_l.append(f(ol))
        outs_c.append(f(oc))
    y_l = gated_rmsnorm(outs_l[0] + outs_l[1], zl, norm_g)
    y_c = gated_rmsnorm(outs_c[0] + outs_c[1], zc, norm_g) if ctx_out else None
    return y_l, y_c


def block_attention(q, k, v):
    b, t, hq, d = q.shape
    hkv = k.shape[2]
    grp = hq // hkv
    nb = t // Q_BLOCK
    qb = q.reshape(b, nb, Q_BLOCK, hkv, grp, d).swapaxes(0, 1)
    scale = d ** -0.5

    def one_block(qi):
        s = jnp.einsum('bqkgd,bskd->bkgqs', qi, k).astype(jnp.float32) * scale
        p = jax.nn.softmax(s, axis=-1).astype(v.dtype)
        return jnp.einsum('bkgqs,bskd->bqkgd', p, v)

    o = lax.map(one_block, qb)
    return o.swapaxes(0, 1).reshape(b, t, hq * d)


def gqa_mixer(parts_l, parts_c, q_norm_g, k_norm_g, cos, sin, ctx_out):
    def heads(q, k, v):
        b, t, _ = q.shape
        return (rmsnorm(q.reshape(b, t, GQA_Q_HEADS, HEAD_DIM), q_norm_g),
                rmsnorm(k.reshape(b, t, GQA_KV_HEADS, HEAD_DIM), k_norm_g),
                v.reshape(b, t, GQA_KV_HEADS, HEAD_DIM))

    ql, kl, vl = heads(*parts_l)
    qc, kc, vc = heads(*parts_c)
    ql = apply_axial_rope(ql, cos, sin)
    kl = apply_axial_rope(kl, cos, sin)
    y_l = block_attention(ql, jnp.concatenate([kl, kc], axis=1), jnp.concatenate([vl, vc], axis=1))
    y_c = block_attention(qc, kc, vc) if ctx_out else None
    return y_l, y_c


def linear_combine(left, right):
    a1, b1 = left
    a2, b2 = right
    return a1 * a2, a2 * b1 + b2


def rglru(x, gate_w, gate_b, lam, h0):
    b, t, _ = x.shape
    xb = x.reshape(b, t, LRU_BLOCKS, LRU_BLOCK)
    gates = jnp.einsum('btnd,gnde->gbtne', xb, gate_w).reshape(2, b, t, W_LRU) + gate_b[:, None, None, :]
    gates = jax.nn.sigmoid(gates.astype(jnp.float32))
    r, i = gates[0], gates[1]
    log_a = -LRU_C * r * jax.nn.softplus(-lam.astype(jnp.float32))
    a = jnp.exp(log_a)
    u = jnp.sqrt(-jnp.expm1(2.0 * log_a)) * (i * x.astype(jnp.float32))
    u = u.at[:, 0].add(a[:, 0] * h0)
    _, h = lax.associative_scan(linear_combine, (a, u), axis=1)
    return h.astype(x.dtype), h[:, -1]


def lru_mixer(parts_l, parts_c, conv_w, conv_b, gate_w, gate_b, lam, ctx_out):
    xl, gl = parts_l
    xc, gc = parts_c
    xl = depthwise_conv(xl, conv_w, LRU_CONV // 2) + conv_b
    xc = depthwise_conv(xc, conv_w, LRU_CONV // 2) + conv_b
    h0 = jnp.zeros((xc.shape[0], W_LRU), jnp.float32)
    outs_l, outs_c = [], []
    for d, f in enumerate((identity, reverse)):
        hc, hc_last = rglru(f(xc), gate_w[d], gate_b[d], lam[d], h0)
        hl, _ = rglru(f(xl), gate_w[d], gate_b[d], lam[d], hc_last)
        outs_l.append(f(hl))
        outs_c.append(f(hc))
    y_l = jax.nn.gelu(gl) * (outs_l[0] + outs_l[1])
    y_c = jax.nn.gelu(gc) * (outs_c[0] + outs_c[1]) if ctx_out else None
    return y_l, y_c


def conv_ffn(h, w_up, conv_w, conv_b, w_down):
    u = depthwise_conv(h @ w_up, conv_w, FFN_CONV // 2) + conv_b
    gate, up = jnp.split(u, 2, axis=-1)
    return (jax.nn.silu(gate) * up) @ w_down


def trunk_layer(x, ctx, mod_l, mod_c, cos, sin, norm1_g, norm2_g, w_in,
                gdn_conv_w, gdn_a_log, gdn_dt_bias, gdn_norm_g, q_norm_g, k_norm_g,
                lru_conv_w, lru_conv_b, lru_gate_w, lru_gate_b, lru_lambda,
                w_out, ffn_w_up, ffn_conv_w, ffn_conv_b, ffn_w_down, ctx_out):
    sh1_l, sc1_l, g1_l, sh2_l, sc2_l, g2_l = jnp.split(mod_l, N_MOD, axis=-1)
    sh1_c, sc1_c, g1_c, sh2_c, sc2_c, g2_c = jnp.split(mod_c, N_MOD, axis=-1)
    h_l = modulate(rmsnorm(x, norm1_g), sh1_l, sc1_l)
    h_c = modulate(rmsnorm(ctx, norm1_g), sh1_c, sc1_c)
    p_l = split_columns(h_l @ w_in)
    p_c = split_columns(h_c @ w_in)
    ya_l, ya_c = gdn_mixer(p_l[0:6], p_c[0:6], gdn_conv_w, gdn_a_log, gdn_dt_bias, gdn_norm_g, ctx_out)
    yb_l, yb_c = gqa_mixer(p_l[6:9], p_c[6:9], q_norm_g, k_norm_g, cos, sin, ctx_out)
    yc_l, yc_c = lru_mixer(p_l[9:11], p_c[9:11], lru_conv_w, lru_conv_b, lru_gate_w, lru_gate_b, lru_lambda, ctx_out)
    x = x + g1_l * (jnp.concatenate([ya_l, yb_l, yc_l], axis=-1) @ w_out)
    x = x + g2_l * conv_ffn(modulate(rmsnorm(x, norm2_g), sh2_l, sc2_l), ffn_w_up, ffn_conv_w, ffn_conv_b, ffn_w_down)
    if ctx_out:
        ctx = ctx + g1_c * (jnp.concatenate([ya_c, yb_c, yc_c], axis=-1) @ w_out)
        ctx = ctx + g2_c * conv_ffn(modulate(rmsnorm(ctx, norm2_g), sh2_c, sc2_c), ffn_w_up, ffn_conv_w, ffn_conv_b, ffn_w_down)
    return x, ctx


def setup_inputs(seed: int = 0) -> dict:
    key = jax.random.key(seed)
    ks = jax.random.split(key, 32)
    f32 = jnp.float32

    def nrm(k, shape, scale):
        return jax.random.normal(k, shape, f32) * scale

    def gain(k, shape):
        return 1.0 + 0.02 * jax.random.normal(k, shape, f32)

    a_init = jax.random.uniform(ks[8], (DEPTH, 2, GDN_HEADS), f32, 1.0, 16.0)
    dt = jnp.exp(jax.random.uniform(ks[9], (DEPTH, 2, GDN_HEADS), f32, math.log(1e-3), math.log(1e-1)))
    a_lru = jax.random.uniform(ks[17], (DEPTH, 2, W_LRU), f32, 0.9, 0.999) ** (1.0 / LRU_C)
    return {
        'x': nrm(ks[0], (BATCH, SEQ, D_MODEL), 1.0),
        'c': nrm(ks[1], (BATCH, D_MODEL), 1.0),
        'ctx': nrm(ks[2], (BATCH, CTX_LEN, D_MODEL), 1.0),
        'c_ctx': nrm(ks[3], (D_MODEL,), 1.0),
        'ada_w': nrm(ks[4], (DEPTH, D_MODEL, N_MOD * D_MODEL), 0.5 * D_MODEL ** -0.5),
        'ada_b': nrm(ks[5], (DEPTH, N_MOD * D_MODEL), 0.02),
        'norm1_g': gain(ks[6], (DEPTH, D_MODEL)),
        'norm2_g': gain(ks[7], (DEPTH, D_MODEL)),
        'w_in': nrm(ks[10], (DEPTH, D_MODEL, IN_COLS), D_MODEL ** -0.5),
        'gdn_conv_w': nrm(ks[11], (DEPTH, GDN_CONV, 3 * W_GDN), GDN_CONV ** -0.5),
        'gdn_a_log': jnp.log(a_init),
        'gdn_dt_bias': dt + jnp.log(-jnp.expm1(-dt)),
        'gdn_norm_g': gain(ks[12], (DEPTH, HEAD_DIM)),
        'q_norm_g': gain(ks[13], (DEPTH, HEAD_DIM)),
        'k_norm_g': gain(ks[14], (DEPTH, HEAD_DIM)),
        'lru_conv_w': nrm(ks[15], (DEPTH, LRU_CONV, W_LRU), LRU_CONV ** -0.5),
        'lru_conv_b': nrm(ks[16], (DEPTH, W_LRU), 0.02),
        'lru_gate_w': nrm(ks[18], (DEPTH, 2, 2, LRU_BLOCKS, LRU_BLOCK, LRU_BLOCK), LRU_BLOCK ** -0.5),
        'lru_gate_b': nrm(ks[19], (DEPTH, 2, 2, W_LRU), 0.02),
        'lru_lambda': jnp.log(a_lru) - jnp.log1p(-a_lru),
        'w_out': nrm(ks[20], (DEPTH, D_MODEL, D_MODEL), D_MODEL ** -0.5),
        'ffn_w_up': nrm(ks[21], (DEPTH, D_MODEL, 2 * FFN_DIM), D_MODEL ** -0.5),
        'ffn_conv_w': nrm(ks[22], (DEPTH, FFN_CONV, 2 * FFN_DIM), FFN_CONV ** -0.5),
        'ffn_conv_b': nrm(ks[23], (DEPTH, 2 * FFN_DIM), 0.02),
        'ffn_w_down': nrm(ks[24], (DEPTH, FFN_DIM, D_MODEL), FFN_DIM ** -0.5),
        'final_norm_g': gain(ks[25], (D_MODEL,)),
    }


def reference(x, c, ctx, c_ctx, ada_w, ada_b, norm1_g, norm2_g, w_in, gdn_conv_w, gdn_a_log, gdn_dt_bias,
              gdn_norm_g, q_norm_g, k_norm_g, lru_conv_w, lru_conv_b, lru_gate_w, lru_gate_b, lru_lambda,
              w_out, ffn_w_up, ffn_conv_w, ffn_conv_b, ffn_w_down, final_norm_g):
    cos, sin = axial_rope_tables(x.shape[1])
    for layer in range(DEPTH):
        mod_l = adaln(c, ada_w[layer], ada_b[layer])[:, None, :]
        mod_c = adaln(c_ctx, ada_w[layer], ada_b[layer])[None, None, :]
        x, ctx = trunk_layer(
            x, ctx, mod_l, mod_c, cos, sin, norm1_g[layer], norm2_g[layer], w_in[layer],
            gdn_conv_w[layer], gdn_a_log[layer], gdn_dt_bias[layer], gdn_norm_g[layer],
            q_norm_g[layer], k_norm_g[layer], lru_conv_w[layer], lru_conv_b[layer],
            lru_gate_w[layer], lru_gate_b[layer], lru_lambda[layer], w_out[layer],
            ffn_w_up[layer], ffn_conv_w[layer], ffn_conv_b[layer], ffn_w_down[layer],
            layer < DEPTH - 1)
    return rmsnorm(x, final_norm_g)
```

```cpp
#include <hip/hip_runtime.h>
#include <hip/hip_bf16.h>
#include <cstdio>
#include <cstdint>
#ifndef MK_ONE_LAUNCH
#define MK_ONE_LAUNCH 1
#endif
#ifndef DUP_PH
#define DUP_PH -1
#endif
#ifndef DUP_SUB
#define DUP_SUB 0
#endif
#ifndef DUP_BAR
#define DUP_BAR 0
#endif
namespace pg8 {
#define PG8_LAS __attribute__((address_space(3)))
typedef unsigned short bf16_t;
typedef short bf16x8 __attribute__((ext_vector_type(8)));
typedef float f32x4 __attribute__((ext_vector_type(4)));
typedef unsigned u32x4 __attribute__((ext_vector_type(4)));
constexpr int BM = 256, BK = 64, HALF = 128, HTB = HALF * BK * 2  , STAGE_BYTES = 8 * HTB, NXCD = 8, WGM = 8;

__host__ __device__ __forceinline__ int lds_byte(int r, int c) { const int st = (r >> 4) * 2 + (c >> 5), rr = r & 15, cc = c & 31, ob = rr * 64 + cc * 2; return st * 1024 + (ob ^ (((ob >> 9) & 1) << 5)); }
__host__ __device__ __forceinline__ void stage_rc(int b, int& R, int& C) { const int st = b / 1024, sb = b % 1024, swz = sb ^ (((sb >> 9) & 1) << 5); R = (st >> 1) * 16 + swz / 64; C = (st & 1) * 32 + (swz % 64) / 2; }
__host__ __device__ __forceinline__ int perm32(int rho) { const int n = rho >> 4, i = rho & 15; return 8 * (i >> 2) + 4 * n + (i & 3); }

struct Unit { int pm, pn, koff, nt, split; };
struct Gemm { const bf16_t* A; const bf16_t* Bt; int M, N, K; };

struct StaticOrder {
    int nM, nN, nwg, G, c, ntk;
    __host__ __device__ void init(int M, int N, int G_, int c_, int K_) { nM = M / BM; nN = N / BM; nwg = nM * nN; G = G_; c = c_; ntk = K_ / BK; }
    __host__ __device__ bool next(int i, Unit& u) const {
        const long L = (long)i * G + c; if (L >= nwg) return false;
        int wgid = (int)L; { const int q = nwg / NXCD, r = nwg % NXCD, xcd = wgid % NXCD, off = wgid / NXCD; wgid = (xcd < r ? xcd * (q + 1) : r * (q + 1) + (xcd - r) * q) + off; }
        const int nig = WGM * nN, gid = wgid / nig, fm = gid * WGM, gsz = (nM - fm) < WGM ? (nM - fm) : WGM;
        u.pm = fm + ((wgid % nig) % gsz); u.pn = (wgid % nig) / gsz; u.koff = 0; u.nt = ntk; u.split = 0; return true;
    }
    __device__ __forceinline__ void a_ready(const Unit&) const {}
    __device__ __forceinline__ void done(const Unit&) const {}
};
struct TailSplitOrder {
    StaticOrder full, all; int G, c, nbk, tail;
    __host__ __device__ void init(int M, int N, int G_, int c_, int K_) { G = G_; c = c_; nbk = K_ / 128; tail = (G_ == 256 && M == 68 * BM && N == 8 * BM) ? 1 : 0; full.init(64 * BM, N, G_, c_, K_); all.init(M, N, G_, c_, K_); }
    __host__ __device__ bool next(int i, Unit& u) const {
        if (!tail) return all.next(i, u);
        if (i < 2) return full.next(i, u);
        if (i > 2) return false;
        const int t = c >> 3, p = c & 7, base = nbk >> 3, rem = nbk & 7, start = p * base + (p < rem ? p : rem), len = base + (p < rem ? 1 : 0);
        u.pm = 64 + (t >> 3); u.pn = t & 7; u.koff = start * 128; u.nt = 2 * len; u.split = p + 1; return true;
    }
    __device__ __forceinline__ void a_ready(const Unit&) const {}
    __device__ __forceinline__ void done(const Unit&) const {}
};


__device__ __forceinline__ unsigned cvt_pk_bf16(float lo, float hi) { unsigned r; asm volatile("v_cvt_pk_bf16_f32 %0, %1, %2" : "=v"(r) : "v"(lo), "v"(hi)); return r; }
typedef float f32x2 __attribute__((ext_vector_type(2)));

struct EpiStoreF32 {
    static constexpr bool PERM = false, AFTER_DRAIN = false;
    float* C; int ldc;
    __device__ __forceinline__ void operator()(const f32x4 (&acc)[2][2][4][2], const Unit& u, int wr, int wc, int fr, int fq) const {
        const int row0 = u.pm * BM + wr * 64 + fr, col0 = u.pn * BM + wc * 32 + 4 * fq;
#pragma unroll
        for (int ai = 0; ai < 2; ++ai)
#pragma unroll
            for (int m = 0; m < 4; ++m) { float* rowp = C + (size_t)(row0 + ai * HALF + m * 16) * ldc + col0;
#pragma unroll
                for (int bj = 0; bj < 2; ++bj)
#pragma unroll
                    for (int n = 0; n < 2; ++n) *(f32x4*)(rowp + bj * HALF + n * 16) = acc[ai][bj][m][n]; }
    }
};
struct EpiResGate {
    static constexpr bool PERM = true, AFTER_DRAIN = false;
    bf16_t* X; int ldc; const float* gate; int gstride; bf16_t* slab;
    __device__ __forceinline__ void operator()(const f32x4 (&acc)[2][2][4][2], const Unit& u, int wr, int wc, int fr, int fq) const {
        const int row0 = u.pm * BM + wr * 64 + fr, col0 = u.pn * BM + wc * 32 + 8 * fq;
        const int bidx = u.pm < 64 ? (u.pm >> 4) : 4;
        const float* gp = gate + (size_t)bidx * gstride + col0;
        f32x4 gv[2][2];
#pragma unroll
        for (int bj = 0; bj < 2; ++bj)
#pragma unroll
            for (int n = 0; n < 2; ++n) gv[bj][n] = *(const f32x4*)(gp + bj * HALF + 4 * n);
        if (u.split) {
            bf16_t* base = slab + ((size_t)(u.split - 1) * 1024 - 16384) * ldc;
#pragma unroll
            for (int ai = 0; ai < 2; ++ai)
#pragma unroll
                for (int m = 0; m < 4; ++m) { bf16_t* rowp = base + (size_t)(row0 + ai * HALF + m * 16) * ldc + col0;
#pragma unroll
                    for (int bj = 0; bj < 2; ++bj) { const f32x4 v0 = gv[bj][0] * acc[ai][bj][m][0], v1 = gv[bj][1] * acc[ai][bj][m][1];
                        u32x4 w; w.x = cvt_pk_bf16(v0[0], v0[1]); w.y = cvt_pk_bf16(v0[2], v0[3]); w.z = cvt_pk_bf16(v1[0], v1[1]); w.w = cvt_pk_bf16(v1[2], v1[3]);
                        *(u32x4*)(rowp + bj * HALF) = w; } }
        } else {
#pragma unroll
            for (int ai = 0; ai < 2; ++ai) { u32x4 x[4][2];
#pragma unroll
                for (int m = 0; m < 4; ++m) { const bf16_t* rowp = X + (size_t)(row0 + ai * HALF + m * 16) * ldc + col0;
#pragma unroll
                    for (int bj = 0; bj < 2; ++bj) x[m][bj] = *(const u32x4*)(rowp + bj * HALF); }
#pragma unroll
                for (int m = 0; m < 4; ++m) { bf16_t* rowp = X + (size_t)(row0 + ai * HALF + m * 16) * ldc + col0;
#pragma unroll
                    for (int bj = 0; bj < 2; ++bj) { const u32x4 xw = x[m][bj];
                        const f32x4 x0 = {__builtin_bit_cast(float, xw.x << 16), __builtin_bit_cast(float, xw.x & 0xffff0000u), __builtin_bit_cast(float, xw.y << 16), __builtin_bit_cast(float, xw.y & 0xffff0000u)};
                        const f32x4 x1 = {__builtin_bit_cast(float, xw.z << 16), __builtin_bit_cast(float, xw.z & 0xffff0000u), __builtin_bit_cast(float, xw.w << 16), __builtin_bit_cast(float, xw.w & 0xffff0000u)};
                        const f32x4 v0 = x0 + gv[bj][0] * acc[ai][bj][m][0], v1 = x1 + gv[bj][1] * acc[ai][bj][m][1];
                        u32x4 w; w.x = cvt_pk_bf16(v0[0], v0[1]); w.y = cvt_pk_bf16(v0[2], v0[3]); w.z = cvt_pk_bf16(v1[0], v1[1]); w.w = cvt_pk_bf16(v1[2], v1[3]);
                        *(u32x4*)(rowp + bj * HALF) = w; } }
                asm volatile("" ::: "memory"); }
        }
    }
};
struct EpiStoreBf16 {
    static constexpr bool PERM = true, AFTER_DRAIN = false;
    bf16_t* O; int ldc;
    __device__ __forceinline__ void operator()(const f32x4 (&acc)[2][2][4][2], const Unit& u, int wr, int wc, int fr, int fq) const {
        const int row0 = u.pm * BM + wr * 64 + fr, col0 = u.pn * BM + wc * 32 + 8 * fq;
#pragma unroll
        for (int ai = 0; ai < 2; ++ai)
#pragma unroll
            for (int m = 0; m < 4; ++m) { bf16_t* rowp = O + (size_t)(row0 + ai * HALF + m * 16) * ldc + col0;
#pragma unroll
                for (int bj = 0; bj < 2; ++bj) { const f32x4 v0 = acc[ai][bj][m][0], v1 = acc[ai][bj][m][1];
                    u32x4 w; w.x = cvt_pk_bf16(v0[0], v0[1]); w.y = cvt_pk_bf16(v0[2], v0[3]); w.z = cvt_pk_bf16(v1[0], v1[1]); w.w = cvt_pk_bf16(v1[2], v1[3]);
                    *(u32x4*)(rowp + bj * HALF) = w; } }
    }
};


struct EpiConvGlu {
    static constexpr bool PERM = true, AFTER_DRAIN = false;
    bf16_t* A; int FFd; const float* cw; const float* cb; float* RAW; PG8_LAS unsigned char* xlds;
    static __device__ __forceinline__ float dpp_ror1(float v) { return __builtin_bit_cast(float, __builtin_amdgcn_mov_dpp(__builtin_bit_cast(int, v), 0x121, 0xf, 0xf, false)); }
    static __device__ __forceinline__ float dpp_ror15(float v) { return __builtin_bit_cast(float, __builtin_amdgcn_mov_dpp(__builtin_bit_cast(int, v), 0x12f, 0xf, 0xf, false)); }
    static __device__ __forceinline__ float silu(float x) { return x * __builtin_amdgcn_rcpf(1.0f + __builtin_amdgcn_exp2f(-1.4426950408889634f * x)); }
    __device__ __forceinline__ void operator()(const f32x4 (&acc)[2][2][4][2], const Unit& u, int wr, int wc, int fr, int fq) const {
        const int cidx = wc * 32 + 8 * fq, col = u.pn * 128 + cidx;
        PG8_LAS float* X = (PG8_LAS float*)xlds;
        if (fr == 0 || fr == 15) {
#pragma unroll
            for (int ai = 0; ai < 2; ++ai) { const int m = fr == 0 ? 0 : 3; PG8_LAS float* dst = X + ((wc * 4 + 2 * ai + wr) * 2 + (fr == 0 ? 0 : 1)) * 64 + 8 * fq;
#pragma unroll
                for (int bj = 0; bj < 2; ++bj) { *(PG8_LAS f32x4*)(dst + bj * 32) = fr == 0 ? acc[ai][bj][0][0] : acc[ai][bj][3][0]; *(PG8_LAS f32x4*)(dst + bj * 32 + 4) = fr == 0 ? acc[ai][bj][0][1] : acc[ai][bj][3][1]; } (void)m; } }
        { const bool top = (wr == 0 && fr < 2), bot = (wr == 1 && fr >= 14);
          if (top || bot) { const int slot = top ? fr : fr - 12; float* dst = RAW + ((size_t)u.pm * 4 + slot) * (2 * FFd) + col;
#pragma unroll
              for (int bj = 0; bj < 2; ++bj) { *(f32x4*)(dst + bj * FFd) = top ? acc[0][bj][0][0] : acc[1][bj][3][0]; *(f32x4*)(dst + bj * FFd + 4) = top ? acc[0][bj][0][1] : acc[1][bj][3][1]; } } }
        asm volatile("s_waitcnt lgkmcnt(0)" ::: "memory"); __builtin_amdgcn_s_barrier(); asm volatile("" ::: "memory");
#pragma unroll
        for (int n = 0; n < 2; ++n) {
            f32x4 wt[2][4];
#pragma unroll
            for (int bj = 0; bj < 2; ++bj) { const float* wp = cw + bj * FFd + col + 4 * n; wt[bj][0] = *(const f32x4*)wp; wt[bj][1] = *(const f32x4*)(wp + 2 * FFd); wt[bj][2] = *(const f32x4*)(wp + 4 * FFd); wt[bj][3] = *(const f32x4*)(cb + bj * FFd + col + 4 * n); }
#pragma unroll
            for (int ai = 0; ai < 2; ++ai) { const int bi = 2 * ai + wr;
                asm volatile("" ::: "memory");
                f32x4 res[4];
#pragma unroll
                for (int bj = 0; bj < 2; ++bj) {
                    const f32x4 w0 = wt[bj][0], w1 = wt[bj][1], w2 = wt[bj][2], bb = wt[bj][3];
                    f32x4 pm1 = {0.f, 0.f, 0.f, 0.f}, ne = {0.f, 0.f, 0.f, 0.f};
                    if (bi > 0) pm1 = *(const PG8_LAS f32x4*)(X + ((wc * 4 + bi - 1) * 2 + 1) * 64 + 8 * fq + bj * 32 + 4 * n);
                    if (bi < 3) ne = *(const PG8_LAS f32x4*)(X + ((wc * 4 + bi + 1) * 2 + 0) * 64 + 8 * fq + bj * 32 + 4 * n);
                    f32x4 ncur;
#pragma unroll
                    for (int q = 0; q < 4; ++q) ncur[q] = dpp_ror15(acc[ai][bj][0][n][q]);
#pragma unroll
                    for (int m = 0; m < 4; ++m) { f32x4 pm, nnext = ne;
#pragma unroll
                        for (int q = 0; q < 4; ++q) { pm[q] = dpp_ror1(acc[ai][bj][m][n][q]); if (m < 3) nnext[q] = dpp_ror15(acc[ai][bj][m < 3 ? m + 1 : 3][n][q]); }
                        const f32x4 prev = fr > 0 ? pm : pm1, next = fr < 15 ? ncur : nnext;
                        const f32x4 c = bb + w0 * prev + w1 * acc[ai][bj][m][n] + w2 * next;
                        if (bj == 0) { res[m][0] = silu(c[0]); res[m][1] = silu(c[1]); res[m][2] = silu(c[2]); res[m][3] = silu(c[3]); } else res[m] = res[m] * c;
                        pm1 = pm; ncur = nnext; __builtin_amdgcn_sched_barrier(0); }
                    }
#pragma unroll
                for (int m = 0; m < 4; ++m) { typedef unsigned u32x2 __attribute__((ext_vector_type(2))); u32x2 o; o.x = cvt_pk_bf16(res[m][0], res[m][1]); o.y = cvt_pk_bf16(res[m][2], res[m][3]);
                    *(u32x2*)(A + (size_t)(u.pm * BM + ai * HALF + wr * 64 + m * 16 + fr) * FFd + col + 4 * n) = o; } } }
    }
};
template <class Epi, class Sched, bool ALIGN_EPI = false, bool SP2 = false>
__device__ __forceinline__ void gemm_phase(PG8_LAS unsigned char* lds, const Gemm g, const Sched& S, const Epi& E) {
    int tid_o = threadIdx.x; asm volatile("" : "+v"(tid_o));
    int tid = tid_o; const int wid = __builtin_amdgcn_readfirstlane(tid >> 6), wr = wid >> 2, wc = wid & 3; int lane = tid & 63, fr = lane & 15, fq = lane >> 4;
    const int K = g.K;
    unsigned voffA[2], voffB[2];
#pragma unroll
    for (int i = 0; i < 2; ++i) { int R, C; stage_rc(tid * 16 + i * 8192, R, C); const int Rb = Epi::PERM ? ((R & ~31) + perm32(R & 31)) : R;
        voffA[i] = (unsigned)(R * K + C) * 2u; voffB[i] = (unsigned)(Rb * K + C) * 2u; }
    const size_t kstep = (size_t)(BK * 2);
    const size_t hstep = (size_t)HALF * K * 2;
    const size_t tstep = 2 * hstep;
    const unsigned ldsw = (unsigned)wid * 1024u;
    int aoff = lds_byte(wr * 64 + fr, fq * 8), boff = lds_byte(wc * 32 + fr, fq * 8);
#define PG8_RELANE() do { tid = threadIdx.x; asm volatile("" : "+v"(tid)); lane = tid & 63; fr = lane & 15; fq = lane >> 4; \
        _Pragma("unroll") for (int i = 0; i < 2; ++i) { int R, C; stage_rc(tid * 16 + i * 8192, R, C); const int Rb = Epi::PERM ? ((R & ~31) + perm32(R & 31)) : R; \
            voffA[i] = (unsigned)(R * K + C) * 2u; voffB[i] = (unsigned)(Rb * K + C) * 2u; } \
        aoff = lds_byte(wr * 64 + fr, fq * 8); boff = lds_byte(wc * 32 + fr, fq * 8); } while (0)
#define PG8_SA(b, h) (((b) * 2 + (h)) * HTB)
#define PG8_SB(b, h) ((4 + (b) * 2 + (h)) * HTB)
#define PG8_STAGE(bufoff, gbase, voff) do { _Pragma("unroll") for (int _i = 0; _i < 2; ++_i) \
        __builtin_amdgcn_global_load_lds((const unsigned*)((const char*)(gbase) + (voff)[_i]), (PG8_LAS unsigned*)(lds + (bufoff) + ldsw + _i * 8192), 16, 0, 0); } while (0)
#define PG8_LDA(dst, b, h) do { _Pragma("unroll") for (int m = 0; m < 4; ++m) _Pragma("unroll") for (int k = 0; k < 2; ++k) dst[m][k] = *(const PG8_LAS bf16x8*)(lds + PG8_SA(b, h) + aoff + m * 2048 + k * 1024); } while (0)
#define PG8_LDB(dst, b, h) do { _Pragma("unroll") for (int n = 0; n < 2; ++n) _Pragma("unroll") for (int k = 0; k < 2; ++k) dst[n][k] = *(const PG8_LAS bf16x8*)(lds + PG8_SB(b, h) + boff + n * 2048 + k * 1024); } while (0)
#define PG8_MMA(ai, bj, At, Bt) do { __builtin_amdgcn_s_setprio(1); _Pragma("unroll") for (int m = 0; m < 4; ++m) _Pragma("unroll") for (int n = 0; n < 2; ++n) _Pragma("unroll") for (int k = 0; k < 2; ++k) \
        acc[ai][bj][m][n] = __builtin_amdgcn_mfma_f32_16x16x32_bf16(Bt[n][k], At[m][k], acc[ai][bj][m][n], 0, 0, 0); __builtin_amdgcn_s_setprio(0); } while (0)
#define PG8_WAIT_V(n) asm volatile("s_waitcnt vmcnt(" #n ")" ::: "memory")
#define PG8_WAIT_L(n) asm volatile("s_waitcnt lgkmcnt(" #n ")" ::: "memory")
#define PG8_BAR __builtin_amdgcn_s_barrier()
#define PG8_SCHED __builtin_amdgcn_sched_barrier(0)
    Unit cur, nxt; int ui = 0;
    if (!S.next(0, cur)) return;
    f32x4 acc[2][2][4][2];
#pragma unroll
    for (int a = 0; a < 2; ++a)
#pragma unroll
        for (int b = 0; b < 2; ++b)
#pragma unroll
            for (int m = 0; m < 4; ++m)
#pragma unroll
                for (int n = 0; n < 2; ++n) acc[a][b][m][n] = (f32x4){0.f, 0.f, 0.f, 0.f};
    bf16x8 At[4][2], B0[2][2], B1[2][2];
    const char* cA = (const char*)g.A + (size_t)cur.pm * tstep + (size_t)cur.koff * 2; const char* cB = (const char*)g.Bt + (size_t)cur.pn * tstep + (size_t)cur.koff * 2;
    S.a_ready(cur);
    if constexpr (SP2) {
        PG8_STAGE(PG8_SB(0, 0), cB, voffB); PG8_STAGE(PG8_SB(0, 1), cB + hstep, voffB); PG8_STAGE(PG8_SA(0, 0), cA, voffA); PG8_STAGE(PG8_SA(0, 1), cA + hstep, voffA);
        if (wr == 1) PG8_BAR;
        PG8_WAIT_V(2); PG8_BAR;
        PG8_STAGE(PG8_SB(1, 0), cB + kstep, voffB); PG8_STAGE(PG8_SA(1, 0), cA + kstep, voffA); PG8_STAGE(PG8_SB(1, 1), cB + hstep + kstep, voffB);
        PG8_WAIT_V(6); PG8_BAR;
    } else {
        PG8_STAGE(PG8_SB(0, 0), cB, voffB); PG8_STAGE(PG8_SA(0, 0), cA, voffA); PG8_STAGE(PG8_SB(0, 1), cB + hstep, voffB); PG8_STAGE(PG8_SA(0, 1), cA + hstep, voffA);
        if (wr == 1) PG8_BAR;
        PG8_WAIT_V(4); PG8_BAR;
        PG8_STAGE(PG8_SB(1, 0), cB + kstep, voffB); PG8_STAGE(PG8_SA(1, 0), cA + kstep, voffA); PG8_STAGE(PG8_SB(1, 1), cB + hstep + kstep, voffB);
        PG8_WAIT_V(6); PG8_BAR;
    }
    for (;;) {
        const bool has_next = S.next(ui + 1, nxt);
        const char* nA = has_next ? (const char*)g.A + (size_t)nxt.pm * tstep + (size_t)nxt.koff * 2 : cA; const char* nB = has_next ? (const char*)g.Bt + (size_t)nxt.pn * tstep + (size_t)nxt.koff * 2 : cB;
        const int nt = cur.nt;
        for (int t = 0; t < nt; t += 2) {
            const bool last = (t == nt - 2);
            const char* a1 = cA + (size_t)(t + 1) * kstep;
            const char* a2 = last ? nA : cA + (size_t)(t + 2) * kstep; const char* b2 = last ? nB : cB + (size_t)(t + 2) * kstep;
            const char* a3 = a2 + kstep; const char* b3 = b2 + kstep;
            if (last && has_next) S.a_ready(nxt);
            if constexpr (SP2) {
            PG8_LDB(B0, 0, 0); PG8_LDB(B1, 0, 1); PG8_SCHED; PG8_LDA(At, 0, 0); PG8_STAGE(PG8_SA(1, 1), a1 + hstep, voffA);
            PG8_WAIT_V(8); PG8_WAIT_L(0); PG8_BAR; PG8_MMA(0, 0, At, B0); PG8_MMA(0, 1, At, B1); PG8_BAR; PG8_SCHED;
            PG8_LDA(At, 0, 1); PG8_STAGE(PG8_SB(0, 0), b2, voffB); PG8_STAGE(PG8_SB(0, 1), b2 + hstep, voffB); PG8_STAGE(PG8_SA(0, 0), a2, voffA);
            PG8_WAIT_V(8); PG8_WAIT_L(0); PG8_BAR; PG8_MMA(1, 0, At, B0); PG8_MMA(1, 1, At, B1); PG8_BAR; PG8_SCHED;
            PG8_LDB(B0, 1, 0); PG8_LDB(B1, 1, 1); PG8_SCHED; PG8_LDA(At, 1, 0); PG8_STAGE(PG8_SA(0, 1), a2 + hstep, voffA);
            PG8_WAIT_V(8); PG8_WAIT_L(0); PG8_BAR; PG8_MMA(0, 0, At, B0); PG8_MMA(0, 1, At, B1); PG8_BAR; PG8_SCHED;
            PG8_LDA(At, 1, 1); PG8_STAGE(PG8_SB(1, 0), b3, voffB); PG8_STAGE(PG8_SB(1, 1), b3 + hstep, voffB); PG8_STAGE(PG8_SA(1, 0), a3, voffA);
            PG8_WAIT_V(8); PG8_WAIT_L(0); PG8_BAR; PG8_MMA(1, 0, At, B0); PG8_MMA(1, 1, At, B1); PG8_BAR; PG8_SCHED;
            } else {
            PG8_LDB(B0, 0, 0); PG8_SCHED; PG8_LDA(At, 0, 0); PG8_STAGE(PG8_SA(1, 1), a1 + hstep, voffA);
            PG8_WAIT_L(8); PG8_BAR; PG8_WAIT_L(0); PG8_MMA(0, 0, At, B0); PG8_BAR; PG8_SCHED;
            PG8_LDB(B1, 0, 1); PG8_STAGE(PG8_SB(0, 0), b2, voffB);
            PG8_BAR; PG8_WAIT_L(0); PG8_MMA(0, 1, At, B1); PG8_BAR;
            PG8_LDA(At, 0, 1); PG8_STAGE(PG8_SA(0, 0), a2, voffA);
            PG8_BAR; PG8_WAIT_L(0); PG8_MMA(1, 0, At, B0); PG8_BAR; PG8_SCHED;
            PG8_STAGE(PG8_SB(0, 1), b2 + hstep, voffB);
            PG8_WAIT_V(6); PG8_BAR; PG8_MMA(1, 1, At, B1); PG8_BAR;
            PG8_LDB(B0, 1, 0); PG8_SCHED; PG8_LDA(At, 1, 0); PG8_STAGE(PG8_SA(0, 1), a2 + hstep, voffA);
            PG8_WAIT_L(8); PG8_BAR; PG8_WAIT_L(0); PG8_MMA(0, 0, At, B0); PG8_BAR; PG8_SCHED;
            PG8_LDB(B1, 1, 1); PG8_STAGE(PG8_SB(1, 0), b3, voffB);
            PG8_BAR; PG8_WAIT_L(0); PG8_MMA(0, 1, At, B1); PG8_BAR;
            PG8_LDA(At, 1, 1); PG8_STAGE(PG8_SA(1, 0), a3, voffA);
            PG8_BAR; PG8_WAIT_L(0); PG8_MMA(1, 0, At, B0); PG8_BAR; PG8_SCHED;
            PG8_STAGE(PG8_SB(1, 1), b3 + hstep, voffB);
            PG8_WAIT_V(6); PG8_BAR; PG8_MMA(1, 1, At, B1); PG8_BAR;
            }
        }
        if constexpr (ALIGN_EPI) { if (wr == 0) PG8_BAR; }
        if constexpr (!Epi::AFTER_DRAIN) { E(acc, cur, wr, wc, fr, fq); S.done(cur); PG8_RELANE(); }
        if (!has_next) break;
#pragma unroll
        for (int a = 0; a < 2; ++a)
#pragma unroll
            for (int b = 0; b < 2; ++b)
#pragma unroll
                for (int m = 0; m < 4; ++m)
#pragma unroll
                    for (int n = 0; n < 2; ++n) acc[a][b][m][n] = (f32x4){0.f, 0.f, 0.f, 0.f};
        cur = nxt; cA = nA; cB = nB; ++ui;
        if constexpr (ALIGN_EPI) { if (wr == 1) PG8_BAR; }
    }
    PG8_WAIT_V(0);
    if constexpr (!ALIGN_EPI) { if (wr == 0) PG8_BAR; }
    PG8_BAR;
    if constexpr (Epi::AFTER_DRAIN) { E.fused(acc, cur, wr, wc, fr, fq, lds, wid, lane); S.done(cur); }
#undef PG8_SA
#undef PG8_SB
#undef PG8_STAGE
#undef PG8_LDA
#undef PG8_LDB
#undef PG8_MMA
#undef PG8_WAIT_V
#undef PG8_WAIT_L
#undef PG8_BAR
#undef PG8_SCHED
#undef PG8_RELANE
}
}
namespace att {
using bf16 = __hip_bfloat16;
constexpr int   D = 128, NW = 8, QBLK = 32, KVBLK = 64;
constexpr float SCALE = 0.088388347648318440f;
constexpr float THR = 8.f;
constexpr int SDEPTH = 2;
constexpr int LDQ = 1024, LDK = 256, LDO = 2048;
constexpr size_t SHM_V = KVBLK * D * 2, SHM_K = KVBLK * D * 2, SHM_ATTN = 2 * SHM_V + 2 * SHM_K + NW * 64 * 4;
__device__ __forceinline__ unsigned short f2bf_rne(float f) { unsigned u = __builtin_bit_cast(unsigned, f); return (unsigned short)((u + 0x7fffu + ((u >> 16) & 1u)) >> 16); }
using bf16x8 = __attribute__((ext_vector_type(8))) short;
using s16x4  = __attribute__((ext_vector_type(4))) short;
using f32x16 = __attribute__((ext_vector_type(16))) float;
using f32x8  = __attribute__((ext_vector_type(8))) float;
using u32x4  = __attribute__((ext_vector_type(4))) unsigned;
#define KSWZ(row, colB) ((row) * 256 + ((colB) ^ (((row) & 7) << 4)))
#define SBAR() __builtin_amdgcn_sched_barrier(0)
__device__ __forceinline__ int crow(int r, int hi) { return (r & 3) + 8 * (r >> 2) + 4 * hi; }
__device__ __forceinline__ unsigned cvtpk(float lo, float hi) {
  unsigned r; asm volatile("v_cvt_pk_bf16_f32 %0, %1, %2" : "=v"(r) : "v"(lo), "v"(hi)); return r;
}
template <typename TIn> struct Stage;
template <> struct Stage<bf16>  { using T = bf16x8;
  __device__ static __forceinline__ T ld8(const bf16* p) { return *reinterpret_cast<const bf16x8*>(p); }
  __device__ static __forceinline__ bf16x8 tobf(T x) { return x; } };
template <> struct Stage<float> { using T = f32x8;
  __device__ static __forceinline__ T ld8(const float* p) { return *reinterpret_cast<const f32x8*>(p); }
  __device__ static __forceinline__ bf16x8 tobf(T x) {
    u32x4 w = {cvtpk(x[0], x[1]), cvtpk(x[2], x[3]), cvtpk(x[4], x[5]), cvtpk(x[6], x[7])}; return *reinterpret_cast<bf16x8*>(&w); } };

__device__ __forceinline__ void partialSM(f32x16& p0, f32x16& p1, float& m_reg, float& mn, float& alpha) {
  constexpr float THR2 = THR * 1.4426950408889634f;
  float pmax = p0[0]; for (int r = 1; r < 16; ++r) pmax = fmaxf(pmax, p0[r]); for (int r = 0; r < 16; ++r) pmax = fmaxf(pmax, p1[r]);
  { auto rr = __builtin_amdgcn_permlane32_swap(__float_as_uint(pmax), __float_as_uint(pmax), false, false);
    pmax = fmaxf(__uint_as_float(rr[0]), __uint_as_float(rr[1])); }
  if (__builtin_expect(__all(pmax - m_reg <= THR2), 1)) { mn = m_reg; alpha = 1.f; }
  else { mn = fmaxf(m_reg, pmax); alpha = __builtin_amdgcn_exp2f(m_reg - mn); m_reg = mn; }
  for (int r = 0; r < 16; ++r) p0[r] = p0[r] - mn; for (int r = 0; r < 16; ++r) p1[r] = p1[r] - mn;
  for (int r = 0; r < 16; ++r) p0[r] = __builtin_amdgcn_exp2f(p0[r]);
}
__device__ __forceinline__ void partialSM_fixed(f32x16& p0, f32x16& p1) {
  for (int r = 0; r < 16; ++r) p0[r] = __builtin_amdgcn_exp2f(p0[r]);
  (void)p1;
}
__device__ __forceinline__ void finishSM(f32x16& p0, f32x16& p1, float alpha, float& l_reg, bf16x8& pa0, bf16x8& pa1, bf16x8& pa2, bf16x8& pa3) {
  for (int r = 0; r < 16; ++r) p1[r] = __builtin_amdgcn_exp2f(p1[r]);
  float ps = 0; for (int r = 0; r < 16; ++r) ps += p0[r]; for (int r = 0; r < 16; ++r) ps += p1[r];
  { auto rr = __builtin_amdgcn_permlane32_swap(__float_as_uint(ps), __float_as_uint(ps), false, false);
    ps = __uint_as_float(rr[0]) + __uint_as_float(rr[1]); }
  l_reg = l_reg * alpha + ps;
#define PK4(P, BASE, OUT) do { unsigned a0 = cvtpk(P[BASE + 0], P[BASE + 1]), a1 = cvtpk(P[BASE + 2], P[BASE + 3]);   \
    unsigned b0 = cvtpk(P[BASE + 4], P[BASE + 5]), b1 = cvtpk(P[BASE + 6], P[BASE + 7]);                              \
    auto r0 = __builtin_amdgcn_permlane32_swap(a0, b0, false, false); auto r1 = __builtin_amdgcn_permlane32_swap(a1, b1, false, false); \
    u32x4 w = {r0[0], r1[0], r0[1], r1[1]}; OUT = *reinterpret_cast<bf16x8*>(&w); } while (0)
  PK4(p0, 0, pa0); PK4(p0, 8, pa1); PK4(p1, 0, pa2); PK4(p1, 8, pa3);
#undef PK4
}
__device__ __forceinline__ void qkt(f32x16& p0, f32x16& p1, const bf16* Ks, const bf16x8* qr, int r32, int hi) {
  p0 = f32x16{}; p1 = f32x16{};
  for (int d0 = 0; d0 < 8; ++d0) { int cb = (d0 * 16 + hi * 8) * 2;
    bf16x8 b0 = *reinterpret_cast<const bf16x8*>((const char*)Ks + KSWZ(r32, cb));
    bf16x8 b1 = *reinterpret_cast<const bf16x8*>((const char*)Ks + KSWZ(32 + r32, cb));
    p0 = __builtin_amdgcn_mfma_f32_32x32x16_bf16(b0, qr[d0], p0, 0, 0, 0);
    p1 = __builtin_amdgcn_mfma_f32_32x32x16_bf16(b1, qr[d0], p1, 0, 0, 0); }
}
__device__ __forceinline__ int v_st(int k, int c) { const int kk = (k & ~0xC) | ((k & 4) << 1) | ((k & 8) >> 1); return ((kk >> 3) * 4 + (c >> 5)) * 512 + ((kk & 7) * 32 + (c & 31)) * 2; }
__device__ __forceinline__ int v_rd_base(int lane) { return ((lane & 3) << 3) | (((lane >> 2) & 3) << 6) | (((lane >> 4) & 1) << 5) | (((lane >> 5) & 1) << 8); }
constexpr int v_rd_off(int d0, int ks, int half) { return d0 * 512 + ks * 4096 + half * 2048; }
template <int OFF> __device__ __forceinline__ s16x4 tr_read(int vb) {
  s16x4 r; asm volatile("ds_read_b64_tr_b16 %0, %1 offset:%2" : "=&v"(r) : "v"(vb), "i"(OFF) : "memory"); return r;
}
template <int D0> __device__ __forceinline__ void pv_one(f32x16& od, int vb, bf16x8 pa0, bf16x8 pa1, bf16x8 pa2, bf16x8 pa3) {
  const s16x4 l0 = tr_read<v_rd_off(D0, 0, 0)>(vb), h0 = tr_read<v_rd_off(D0, 0, 1)>(vb), l1 = tr_read<v_rd_off(D0, 1, 0)>(vb), h1 = tr_read<v_rd_off(D0, 1, 1)>(vb);
  const s16x4 l2 = tr_read<v_rd_off(D0, 2, 0)>(vb), h2 = tr_read<v_rd_off(D0, 2, 1)>(vb), l3 = tr_read<v_rd_off(D0, 3, 0)>(vb), h3 = tr_read<v_rd_off(D0, 3, 1)>(vb);
  asm volatile("s_waitcnt lgkmcnt(0)" ::: "memory"); SBAR();
#define PK(L, H) (bf16x8){L[0], L[1], L[2], L[3], H[0], H[1], H[2], H[3]}
  od = __builtin_amdgcn_mfma_f32_32x32x16_bf16(pa0, PK(l0, h0), od, 0, 0, 0);
  od = __builtin_amdgcn_mfma_f32_32x32x16_bf16(pa1, PK(l1, h1), od, 0, 0, 0);
  od = __builtin_amdgcn_mfma_f32_32x32x16_bf16(pa2, PK(l2, h2), od, 0, 0, 0);
  od = __builtin_amdgcn_mfma_f32_32x32x16_bf16(pa3, PK(l3, h3), od, 0, 0, 0);
#undef PK
}
__device__ __forceinline__ void pv_d0(f32x16* o, int vb, bf16x8 pa0, bf16x8 pa1, bf16x8 pa2, bf16x8 pa3) {
  pv_one<0>(o[0], vb, pa0, pa1, pa2, pa3); pv_one<1>(o[1], vb, pa0, pa1, pa2, pa3); pv_one<2>(o[2], vb, pa0, pa1, pa2, pa3); pv_one<3>(o[3], vb, pa0, pa1, pa2, pa3);
}

template <typename TQ, bool FIXED>
__device__ __forceinline__ void attn_dense_body(const TQ* __restrict__ Qb, const bf16* __restrict__ Kh, const bf16* __restrict__ Vh,
                                                unsigned short* __restrict__ Ob, int seq, char* lds) {
  using St = Stage<bf16>; using SQ = Stage<TQ>;
  int tid_o = threadIdx.x; asm volatile("" : "+v"(tid_o));
  const int tid = tid_o, wid = tid >> 6, lane = tid & 63, r32 = lane & 31, hi = lane >> 5;
  bf16* V_lds = (bf16*)lds; bf16* K_lds = (bf16*)(lds + 2 * SHM_V);
  float* ws = (float*)(lds + 2 * SHM_V + 2 * SHM_K) + wid * 64; float* li_l = ws; float* al_l = ws + 32;
  float m_reg = -1e30f, l_reg = 0; f32x16 o[4] = {}; bf16x8 qr[8];
  const TQ* Qw = Qb + (long)(wid * QBLK + r32) * LDQ + hi * 8;
#pragma unroll
  for (int d0 = 0; d0 < 8; ++d0) qr[d0] = SQ::tobf(SQ::ld8(Qw + d0 * 16));
  const int sr = tid >> 4, sc = (tid & 15) * 8, vst0 = v_st(sr, sc), vst1 = v_st(32 + sr, sc);
  const int vb0 = (int)(uintptr_t)V_lds + v_rd_base(lane);
  struct { typename St::T vs0, vs1, ks0, ks1; } sr_[SDEPTH];
#define SLOAD(i, k0) do { sr_[i].vs0 = St::ld8(&Vh[(long)((k0) + sr) * LDK + sc]); sr_[i].vs1 = St::ld8(&Vh[(long)((k0) + 32 + sr) * LDK + sc]); \
    sr_[i].ks0 = St::ld8(&Kh[(long)((k0) + sr) * LDK + sc]); sr_[i].ks1 = St::ld8(&Kh[(long)((k0) + 32 + sr) * LDK + sc]); } while (0)
#define SWRITE(b, i) do { *(bf16x8*)((char*)V_lds + (b) * SHM_V + vst0) = St::tobf(sr_[i].vs0);          \
    *(bf16x8*)((char*)V_lds + (b) * SHM_V + vst1) = St::tobf(sr_[i].vs1); int kc = sc * 2;               \
    *(bf16x8*)((char*)K_lds + (b) * SHM_K + KSWZ(sr, kc)) = St::tobf(sr_[i].ks0);                       \
    *(bf16x8*)((char*)K_lds + (b) * SHM_K + KSWZ(32 + sr, kc)) = St::tobf(sr_[i].ks1); } while (0)
#define SWAIT() do { if constexpr (SDEPTH == 2) asm volatile("s_waitcnt vmcnt(4)" ::: "memory"); else asm volatile("s_waitcnt vmcnt(0)" ::: "memory"); } while (0)
#define RESC(a) do { if (__any((a) < 1.f)) { if (hi == 0) al_l[r32] = (a); asm volatile("s_waitcnt lgkmcnt(0)" ::: "memory"); \
    for (int d = 0; d < 4; ++d) for (int r = 0; r < 16; ++r) o[d][r] *= al_l[crow(r, hi)]; } } while (0)
#define PSM(P0, P1, MN, AL) do { if constexpr (FIXED) { partialSM_fixed(P0, P1); AL = 1.f; MN = 0.f; } else partialSM(P0, P1, m_reg, MN, AL); } while (0)
  f32x16 pA0, pA1, pB0, pB1; float mnA, mnB, alA, alB; bf16x8 pa0, pa1, pa2, pa3; const int NT = seq / KVBLK;
  constexpr int SE = 0, SO = SDEPTH - 1;
  SLOAD(SE, 0); asm volatile("s_waitcnt vmcnt(0)" ::: "memory"); SWRITE(0, SE); __syncthreads();
  qkt(pA0, pA1, K_lds, qr, r32, hi); PSM(pA0, pA1, mnA, alA);
  SLOAD(SO, KVBLK); if constexpr (SDEPTH == 2) { if (2 < NT) SLOAD(SE, 2 * KVBLK); }
  SWAIT(); SWRITE(1, SO); __syncthreads();
  for (int j = 1; j + 1 < NT; j += 2) {
    SBAR(); qkt(pB0, pB1, (bf16*)((char*)K_lds + SHM_K), qr, r32, hi);
    finishSM(pA0, pA1, alA, l_reg, pa0, pa1, pa2, pa3); SBAR();
    SLOAD(SO, (j + SDEPTH) * KVBLK); SBAR();
    pv_d0(o, vb0, pa0, pa1, pa2, pa3); PSM(pB0, pB1, mnB, alB);
    __syncthreads(); SWAIT(); SWRITE(0, SE);
    RESC(alB); __syncthreads();
    SBAR(); qkt(pA0, pA1, K_lds, qr, r32, hi);
    finishSM(pB0, pB1, alB, l_reg, pa0, pa1, pa2, pa3); SBAR();
    if (SDEPTH == 1 || j + 3 < NT) SLOAD(SE, (j + 1 + SDEPTH) * KVBLK); SBAR();
    pv_d0(o, vb0 + (int)SHM_V, pa0, pa1, pa2, pa3); PSM(pA0, pA1, mnA, alA);
    __syncthreads(); SWAIT(); SWRITE(1, SO);
    RESC(alA); __syncthreads();
  }
  SBAR(); qkt(pB0, pB1, (bf16*)((char*)K_lds + SHM_K), qr, r32, hi);
  finishSM(pA0, pA1, alA, l_reg, pa0, pa1, pa2, pa3); SBAR();
  pv_d0(o, vb0, pa0, pa1, pa2, pa3); PSM(pB0, pB1, mnB, alB);
  __syncthreads(); RESC(alB);
  finishSM(pB0, pB1, alB, l_reg, pa0, pa1, pa2, pa3); SBAR();
  pv_d0(o, vb0 + (int)SHM_V, pa0, pa1, pa2, pa3);
  if (hi == 0) li_l[r32] = l_reg; asm volatile("s_waitcnt lgkmcnt(0)" ::: "memory");
  float rli[16];
#pragma unroll
  for (int r = 0; r < 16; ++r) rli[r] = __builtin_amdgcn_rcpf(li_l[crow(r, hi)]);
  unsigned short* Ow = Ob + (long)(wid * QBLK) * LDO;
#pragma unroll
  for (int r = 0; r < 16; ++r) { int orow = crow(r, hi);
    for (int d0 = 0; d0 < 4; ++d0) Ow[(long)orow * LDO + d0 * 32 + r32] = f2bf_rne(o[d0][r] * rli[r]); }
#undef SLOAD
#undef SWRITE
#undef SWAIT
#undef RESC
#undef PSM
}
}

constexpr int DM = 2048, NBATCH = 4, SEQ = 4096, CTXL = 256, DEPTH = 4;
constexpr int ML = NBATCH * SEQ, MC = NBATCH * CTXL, MT = ML + MC;
constexpr int NINP = 4608;
constexpr int FF = 5504, FF2 = 11008, NMODV = 12288;
constexpr int SKV = SEQ + CTXL;
constexpr float EPS = 1e-6f;
constexpr int PC_QKV = 0, PC_Z = 1536, PC_GQ = 2048, PC_GK = 3072, PC_GV = 3328, PC_LX = 3584, PC_LG = 4096, PC_SM = 4608;
constexpr int NCHUNK = MT / 64;
constexpr int NGTASK = NCHUNK * 8;

constexpr size_t MiB = 1u << 20;
constexpr size_t WS_CTL = 0, CTL_ZERO_BYTES = 1 * MiB;
constexpr size_t WS_MOD = 1 * MiB, WS_ROPE = 2 * MiB, WS_MODP = 3 * MiB;
constexpr size_t WS_WIN = 11 * MiB, WS_WOUT = 30 * MiB, WS_WUP = 38 * MiB, WS_WDN = 81 * MiB;
constexpr size_t WS_X = 103 * MiB, WS_H = 239 * MiB, WS_Y = 307 * MiB, WS_QB = 375 * MiB, WS_KB = 409 * MiB, WS_VB = 418 * MiB;
constexpr size_t WS_BIG = 427 * MiB;
constexpr size_t WS_P = WS_BIG, WS_PS = WS_BIG + 160 * MiB, WS_QKVC = WS_BIG + 324 * MiB, WS_LAB = WS_BIG + 426 * MiB, WS_GT = WS_BIG + 428 * MiB, WS_GG = WS_BIG + 616 * MiB;
constexpr size_t WS_OF = WS_BIG + 617 * MiB, WS_OB = WS_BIG + 651 * MiB, WS_XC = WS_BIG + 685 * MiB, WS_LA = WS_BIG + 719 * MiB, WS_LU = WS_BIG + 787 * MiB;
constexpr size_t WS_LCT = WS_BIG + 855 * MiB, WS_LCI = WS_BIG + 858 * MiB, WS_MIX_END = WS_BIG + 860 * MiB;
constexpr int GT_NW = 0, GT_QD = 16384, GT_KT = 32768, GT_AT = 49152, GT_UT = 57344, GT_BYTES = 73728;
constexpr size_t WS_U = WS_BIG, WS_A = WS_BIG + 366 * MiB, WS_FFN_END = WS_BIG + 549 * MiB;
constexpr size_t WS_WSET1 = WS_MIX_END;
constexpr size_t WS_SLAB = WS_WSET1 + 92 * MiB;
constexpr size_t WS_END = WS_SLAB + 64 * MiB;
constexpr size_t WS_GWT = WS_WDN + 22 * MiB - 512 * 1024;
constexpr int NINW = 4672;
static_assert((size_t)MT * NINP * 2 <= 160 * MiB && (size_t)MT * 1536 * 4 <= 102 * MiB && (size_t)NGTASK * GT_BYTES <= 188 * MiB && (size_t)NGTASK * 65 * 4 <= 1 * MiB, "ws map");
static_assert((size_t)MT * FF2 * 2 <= 366 * MiB && (size_t)MT * FF * 2 <= 183 * MiB && (size_t)2 * MT * 512 * 4 <= 68 * MiB, "ws map");
static_assert((size_t)NINW * DM * 2 <= 19 * MiB && WS_WDN + 22 * MiB - WS_WIN <= 92 * MiB && (size_t)DM * FF * 2 <= 22 * MiB - 512 * 1024 && (size_t)FF2 * DM * 2 <= 43 * MiB && (size_t)DM * FF * 2 <= 22 * MiB && (size_t)8 * 4 * 5 * NMODV * 4 <= 8 * MiB, "ws map");
constexpr int CW_TMO = 0, CW_CODE = 1, CW_BAR = 4096;

constexpr int LDS_BYTES = 163840;
constexpr int MISC_OFF = LDS_BYTES - 256;
constexpr int PH_LDS = MISC_OFF;

#define GAS __attribute__((address_space(1)))
#define LAS __attribute__((address_space(3)))
#define DI __device__ __forceinline__
typedef unsigned short bf16;
typedef unsigned v4u __attribute__((ext_vector_type(4)));
typedef unsigned v2u __attribute__((ext_vector_type(2)));
typedef float f32x4 __attribute__((ext_vector_type(4)));
typedef float f32x2 __attribute__((ext_vector_type(2)));
typedef float f32x16 __attribute__((ext_vector_type(16)));
typedef short bf16x8 __attribute__((ext_vector_type(8)));
typedef GAS unsigned gu32;
#define RLX_AGENT __ATOMIC_RELAXED, __HIP_MEMORY_SCOPE_AGENT
#define LDS_WAIT() asm volatile("s_waitcnt lgkmcnt(0)" ::: "memory")
#define VM_WAIT() asm volatile("s_waitcnt vmcnt(0)" ::: "memory")
#define BAR_LDS() do { asm volatile("s_waitcnt lgkmcnt(0)" ::: "memory"); __builtin_amdgcn_s_barrier(); asm volatile("" ::: "memory"); } while (0)
DI unsigned f2bf(float f) { unsigned u = __builtin_bit_cast(unsigned, f); return (u + 0x7fffu + ((u >> 16) & 1u)) >> 16; }
typedef __bf16 bf16x2v __attribute__((ext_vector_type(2)));
DI unsigned pk2(float lo, float hi) { f32x2 v = {lo, hi}; bf16x2v r = __builtin_convertvector(v, bf16x2v); return __builtin_bit_cast(unsigned, r); }
DI float bf_lo(unsigned w) { return __builtin_bit_cast(float, w << 16); }
DI float bf_hi(unsigned w) { return __builtin_bit_cast(float, w & 0xffff0000u); }

#define XB_TMO      128
#define XB_XCNT(j)  (256  + 64 * (j))
#define XB_XSUB(j)  (1280 + 64 * (j))
#define XB_XGEN(j)  (2304 + 64 * (j))
#define XB_TOP      3328
#define XB_TOPGEN   3392
#define XCD_BAR_WORDS 3456
#define XB_SPIN_CAP (1u << 18)

__device__ __forceinline__ unsigned xb_ld(unsigned* p)              { return __hip_atomic_load(p, __ATOMIC_RELAXED, __HIP_MEMORY_SCOPE_AGENT); }
__device__ __forceinline__ unsigned xb_add(unsigned* p, unsigned v) { return __hip_atomic_fetch_add(p, v, __ATOMIC_RELAXED, __HIP_MEMORY_SCOPE_AGENT); }
__device__ __forceinline__ unsigned xb_xcc_id() { return (unsigned)__builtin_amdgcn_s_getreg((3 << 11) | 20) & 0xFu; }
#define XB_SPIN(cond, bar) do { unsigned _sp = 0; while (cond) { __builtin_amdgcn_s_sleep(1); \
    if ((++_sp & 255u) == 0u) { if (xb_ld(&(bar)[XB_TMO])) break; if (_sp > XB_SPIN_CAP) { atomicAdd(&(bar)[XB_TMO], 1u); break; } } } } while (0)

struct XcdBarrier {
    unsigned* bar; unsigned x;
    volatile LAS unsigned* st;
};
__device__ __forceinline__ XcdBarrier xcd_barrier_post(unsigned* bar, volatile LAS unsigned* st) {
    XcdBarrier b; b.bar = bar; b.x = xb_xcc_id(); b.st = st;
    if (threadIdx.x == 0) (void)xb_add(&bar[XB_XCNT(b.x)], 1u);
    return b;
}
__device__ __forceinline__ void xcd_barrier_complete(unsigned* bar, unsigned x, unsigned& nloc, unsigned& nx) {
    const unsigned G = gridDim.x * gridDim.y * gridDim.z;
    unsigned sum, cnt, mine, sp = 0u;
    for (;;) {
        sum = 0u; cnt = 0u; mine = 0u;
#pragma unroll
        for (unsigned j = 0; j < 16; ++j) { const unsigned c = xb_ld(&bar[XB_XCNT(j)]); sum += c; cnt += (c > 0u) ? 1u : 0u; mine = (j == x) ? c : mine; }
        if (sum == G) break;
        __builtin_amdgcn_s_sleep(1);
        if ((++sp & 255u) == 0u) { if (xb_ld(&bar[XB_TMO])) break; if (sp > XB_SPIN_CAP) { atomicAdd(&bar[XB_TMO], 1u); break; } }
    }
    nloc = mine > 0u ? mine : 1u; nx = cnt > 0u ? cnt : 1u;
}
__device__ __forceinline__ void xcd_barrier(const XcdBarrier& b) {
    asm volatile("s_waitcnt vmcnt(0)" ::: "memory");
    __syncthreads();
    if (threadIdx.x == 0) {
        unsigned* bar = b.bar;
        __builtin_amdgcn_s_waitcnt(0);
        unsigned nloc = b.st[0], nx = b.st[1];
        if (nloc == 0u) { xcd_barrier_complete(bar, b.x, nloc, nx); b.st[0] = nloc; b.st[1] = nx; }
        const unsigned old = xb_add(&bar[XB_XSUB(b.x)], 1u);
        const unsigned gen = old / nloc;
        if (old + 1u == (gen + 1u) * nloc) {
            __builtin_amdgcn_fence(__ATOMIC_RELEASE, "agent");
            asm volatile("s_waitcnt vmcnt(0)" ::: "memory");
            const unsigned og = xb_add(&bar[XB_TOP], 1u);
            const unsigned tg = og / nx;
            if (og + 1u == (tg + 1u) * nx) xb_add(&bar[XB_TOPGEN], 1u);
            else XB_SPIN(xb_ld(&bar[XB_TOPGEN]) == tg, bar);
            __builtin_amdgcn_fence(__ATOMIC_ACQUIRE, "agent");
            xb_add(&bar[XB_XGEN(b.x)], 1u);
            asm volatile("s_waitcnt vmcnt(0)" ::: "memory");
        } else {
            XB_SPIN(xb_ld(&bar[XB_XGEN(b.x)]) == gen, bar);
            __builtin_amdgcn_fence(__ATOMIC_ACQUIRE, "agent");
            asm volatile("s_waitcnt vmcnt(0)" ::: "memory");
        }
    }
    __syncthreads();
}

DI float wave_sum(float v) {
#pragma unroll
    for (int o = 1; o < 64; o <<= 1) v += __shfl_xor(v, o);
    return v;
}
DI float fexp_(float x) { return __builtin_amdgcn_exp2f(x * 1.4426950408889634f); }
DI float frcp_(float x) { return __builtin_amdgcn_rcpf(x); }
DI float sigmoidf_(float x) { return frcp_(1.0f + fexp_(-x)); }
DI float siluf_(float x) { return x * frcp_(1.0f + fexp_(-x)); }
DI float softplusf_(float x) { return fmaxf(x, 0.0f) + log1pf(expf(-fabsf(x))); }
DI float gelu_tanhf_(float x) { const float y = 0.7978845608028654f * (x + 0.044715f * x * x * x); const float t = 1.0f - 2.0f * frcp_(1.0f + fexp_(2.0f * y)); return 0.5f * x * (1.0f + t); }
struct RowInfo { int b, t, T; };
DI RowInfo row_info(int m) { RowInfo r; if (m < ML) { r.b = m >> 12; r.t = m & 4095; r.T = SEQ; } else { const int mm = m - ML; r.b = mm >> 8; r.t = mm & 255; r.T = CTXL; } return r; }
DI int chain_chunk(int b, int dir, int k) { return dir == 0 ? (k < 4 ? 256 + b * 4 + k : b * 64 + (k - 4)) : (k < 4 ? 256 + b * 4 + (3 - k) : b * 64 + (63 - (k - 4))); }
DI void sincos_d(float ang, float& s, float& c) {
    const double a = (double)ang; const double k = __builtin_rint(a * 0.15915494309189535); const double r = a - k * 6.283185307179586477;
    const double r2 = r * r; double ts = r, tc = 1.0, ss = r, cc = 1.0;
#pragma unroll
    for (int n = 1; n <= 14; ++n) { tc = -tc * r2 / (double)((2 * n - 1) * (2 * n)); cc += tc; ts = -ts * r2 / (double)((2 * n) * (2 * n + 1)); ss += ts; }
    s = (float)ss; c = (float)cc;
}
DI int gperm16(int kk) { return ((kk >> 2) & 1) * 8 + (kk >> 3) * 4 + (kk & 3); }
DI int gperm(int k) { return (k & ~15) | gperm16(k & 15); }
DI int crow32(int r, int hf) { return (r & 3) + 8 * (r >> 2) + 4 * hf; }
DI bf16x8 pack_acc(const f32x16& x, int s) { v4u w; w.x = pk2(x[8 * s + 0], x[8 * s + 1]); w.y = pk2(x[8 * s + 2], x[8 * s + 3]); w.z = pk2(x[8 * s + 4], x[8 * s + 5]); w.w = pk2(x[8 * s + 6], x[8 * s + 7]); return __builtin_bit_cast(bf16x8, w); }

DI void ph_prologue_a(const float* x, const float* ctx, const float* c, const float* cctx, const float* ada_w, bf16* X, float* ROPE, float* MODP,
                      LAS unsigned char* lds, int bid, int G, int tid) {
    const size_t nx8 = (size_t)ML * DM / 8, nc8 = (size_t)MC * DM / 8;
    for (size_t i = (size_t)bid * 512 + tid; i < nx8 + nc8; i += (size_t)G * 512) {
        const f32x4* src = i < nx8 ? (const f32x4*)x + 2 * i : (const f32x4*)ctx + 2 * (i - nx8);
        const f32x4 v0 = __builtin_nontemporal_load(src), v1 = __builtin_nontemporal_load(src + 1);
        v4u o; o.x = pk2(v0.x, v0.y); o.y = pk2(v0.z, v0.w); o.z = pk2(v1.x, v1.y); o.w = pk2(v1.z, v1.w);
        ((v4u*)X)[i] = o; }
    { const int idx = bid * 512 + tid;
      if (idx < 64 * 32) { const int pos = idx >> 5, f = idx & 31;
          double inv = 1.0; for (int j = 0; j < f; ++j) inv *= 0.74989420933245582730;
          const float ang = (float)pos * (float)inv; float s, cc; sincos_d(ang, s, cc); ROPE[idx * 2] = cc; ROPE[idx * 2 + 1] = s; } }
    LAS float* sl = (LAS float*)lds;
    for (int it = bid; it < 4 * 8 * 24; it += G) {
        const int L = it / 192, r = it % 192, kc = r / 24, nb = r % 24, n = nb * 512 + tid, k0 = kc * 256;
        __syncthreads();
        for (int e = tid; e < 5 * 256; e += 512) { const int i = e >> 8, kk = e & 255; const float cv = i < 4 ? c[i * DM + k0 + kk] : cctx[k0 + kk]; sl[e] = siluf_(cv); }
        __syncthreads();
        float acc[5] = {0.f, 0.f, 0.f, 0.f, 0.f};
        const float* wp = ada_w + ((size_t)L * DM + k0) * NMODV + n;
#pragma unroll 16
        for (int kk = 0; kk < 256; ++kk) { const float w = __builtin_nontemporal_load(wp + (size_t)kk * NMODV);
#pragma unroll
            for (int i = 0; i < 5; ++i) acc[i] += sl[i * 256 + kk] * w; }
#pragma unroll
        for (int i = 0; i < 5; ++i) MODP[((size_t)(kc * 4 + L) * 5 + i) * NMODV + n] = acc[i];
    }
}
DI void ph_prologue_b(const float* ada_b, const float* MODP, float* MOD, int bid, int G, int tid) {
    for (int idx = bid * 512 + tid; idx < 4 * 5 * NMODV; idx += G * 512) {
        const int L = idx / (5 * NMODV), n = idx % NMODV; float s = ada_b[L * NMODV + n];
#pragma unroll
        for (int kc = 0; kc < 8; ++kc) s += MODP[(size_t)kc * (4 * 5 * NMODV) + idx];
        MOD[idx] = s; }
}
template <int MAP> DI void transpose_item(const float* W, int K, int Nsrc, bf16* WT, LAS float* scr, int item, int nblk, int lane) {
    const int kb = item / nblk, nb = item % nblk, k0 = 64 * kb, n0 = 64 * nb;
    const int np = n0 + lane;
    const int col = MAP == 1 ? (np < 2048 ? np : (np < 4608 ? np + 16 : (np < 4624 ? np - 2560 : -1))) : (MAP == 2 ? ((np >> 7) & 1) * FF + (np >> 8) * 128 + (np & 127) : np);
    const float* src = W + (size_t)k0 * Nsrc + (col >= 0 ? col : 0);
#pragma unroll
    for (int h = 0; h < 2; ++h) { float v[32];
#pragma unroll
        for (int i = 0; i < 32; ++i) v[i] = __builtin_nontemporal_load(src + (size_t)(32 * h + i) * Nsrc);
#pragma unroll
        for (int i = 0; i < 32; ++i) scr[(32 * h + i) * 65 + lane] = col >= 0 ? v[i] : 0.f; }
    LDS_WAIT(); asm volatile("" ::: "memory");
    const int c = lane & 7;
#pragma unroll
    for (int j = 0; j < 8; ++j) { const int n = (lane >> 3) + 8 * j; const LAS float* s = scr + (8 * c) * 65 + n;
        v4u o; o.x = pk2(s[0 * 65], s[1 * 65]); o.y = pk2(s[2 * 65], s[3 * 65]); o.z = pk2(s[4 * 65], s[5 * 65]); o.w = pk2(s[6 * 65], s[7 * 65]);
        __builtin_nontemporal_store(o, (v4u*)(WT + (size_t)(n0 + n) * K + k0 + 8 * c)); }
    LDS_WAIT(); asm volatile("" ::: "memory");
}
DI void ph_wconv(const float* w_in, const float* w_out, const float* w_up, const float* w_dn, const float* gate_w, bf16* WIN, bf16* WOUT, bf16* WUP, bf16* WDN, bf16* GWT,
                 LAS unsigned char* lds, int gw, int ngw, int wave, int lane) {
    for (int idx = gw * 64 + lane; idx < 2 * 2 * 8 * 64 * 64; idx += ngw * 64) { const int dd = idx & 63, e = (idx >> 6) & 63, hi = idx >> 12; GWT[idx] = (bf16)f2bf(gate_w[(size_t)hi * 4096 + dd * 64 + e]); }
    LAS float* scr = (LAS float*)(lds + wave * 16640);
    constexpr int I_IN = (DM / 64) * (NINW / 64), I_OUT = (DM / 64) * (DM / 64), I_UP = (DM / 64) * (FF2 / 64), I_DN = (FF / 64) * (DM / 64);
    for (int it = gw; it < I_IN + I_OUT + I_UP + I_DN; it += ngw) {
        int r = it;
        if (r < I_IN) { transpose_item<1>(w_in, DM, 4624, WIN, scr, r, NINW / 64, lane); continue; } r -= I_IN;
        if (r < I_OUT) { transpose_item<0>(w_out, DM, DM, WOUT, scr, r, DM / 64, lane); continue; } r -= I_OUT;
        if (r < I_UP) { transpose_item<2>(w_up, DM, FF2, WUP, scr, r, FF2 / 64, lane); continue; } r -= I_UP;
        transpose_item<0>(w_dn, FF, DM, WDN, scr, r, DM / 64, lane);
    }
}
struct NormLd { v4u xb[4]; };
DI void norm_issue(NormLd& L, const bf16* X, int m, int lane) {
    const v4u* xr = (const v4u*)(X + (size_t)m * DM) + lane;
#pragma unroll
    for (int j = 0; j < 4; ++j) L.xb[j] = xr[64 * j];
    asm volatile("" ::: "memory");
}
DI void norm_row(const NormLd& L, int m, bf16* X, const float* g, const float* modL, int shoff, int scoff, bf16* H, const bf16* slab, int lane) {
    {
        const int bidx = m < ML ? (m >> 12) : 4; const float* mod = modL + (size_t)bidx * NMODV;
        v4u* xr = (v4u*)(X + (size_t)m * DM) + lane;
        v4u xb[4]; f32x4 v[8]; float ss = 0.f;
#pragma unroll
        for (int j = 0; j < 4; ++j) xb[j] = L.xb[j];
#pragma unroll
        for (int j = 0; j < 4; ++j) { v[2 * j] = (f32x4){bf_lo(xb[j].x), bf_hi(xb[j].x), bf_lo(xb[j].y), bf_hi(xb[j].y)}; v[2 * j + 1] = (f32x4){bf_lo(xb[j].z), bf_hi(xb[j].z), bf_lo(xb[j].w), bf_hi(xb[j].w)}; }
        if (slab != nullptr && m >= ML) {
#pragma unroll
            for (int p = 0; p < 8; p += 4) { const v4u* s0 = (const v4u*)(slab + ((size_t)p * 1024 + (m - ML)) * DM) + lane;
                v4u t[4][4];
#pragma unroll
                for (int q = 0; q < 4; ++q)
#pragma unroll
                    for (int j = 0; j < 4; ++j) t[q][j] = __builtin_nontemporal_load(s0 + (size_t)q * (1024 * DM / 8) + 64 * j);
#pragma unroll
                for (int q = 0; q < 4; ++q)
#pragma unroll
                    for (int j = 0; j < 4; ++j) { v[2 * j] += (f32x4){bf_lo(t[q][j].x), bf_hi(t[q][j].x), bf_lo(t[q][j].y), bf_hi(t[q][j].y)}; v[2 * j + 1] += (f32x4){bf_lo(t[q][j].z), bf_hi(t[q][j].z), bf_lo(t[q][j].w), bf_hi(t[q][j].w)}; } }
#pragma unroll
            for (int j = 0; j < 4; ++j) { v4u o; o.x = pk2(v[2 * j].x, v[2 * j].y); o.y = pk2(v[2 * j].z, v[2 * j].w); o.z = pk2(v[2 * j + 1].x, v[2 * j + 1].y); o.w = pk2(v[2 * j + 1].z, v[2 * j + 1].w); xr[64 * j] = o; } }
#pragma unroll
        for (int j = 0; j < 8; ++j) ss += (v[j].x * v[j].x + v[j].y * v[j].y) + (v[j].z * v[j].z + v[j].w * v[j].w);
        f32x4 gg[8], sc[8], sh[8];
#pragma unroll
        for (int j = 0; j < 8; ++j) { const int col = 512 * (j >> 1) + 8 * lane + 4 * (j & 1); gg[j] = *(const f32x4*)(g + col); sc[j] = *(const f32x4*)(mod + scoff + col); sh[j] = *(const f32x4*)(mod + shoff + col); }
        const float rstd = 1.0f / sqrtf(wave_sum(ss) * (1.0f / DM) + EPS);
        v4u* o16 = (v4u*)(H + (size_t)m * DM) + lane;
#pragma unroll
        for (int j = 0; j < 4; ++j) { const f32x4 y0 = (v[2 * j] * rstd * gg[2 * j]) * (sc[2 * j] + 1.0f) + sh[2 * j], y1 = (v[2 * j + 1] * rstd * gg[2 * j + 1]) * (sc[2 * j + 1] + 1.0f) + sh[2 * j + 1];
            v4u o; o.x = pk2(y0.x, y0.y); o.y = pk2(y0.z, y0.w); o.z = pk2(y1.x, y1.y); o.w = pk2(y1.z, y1.w); o16[64 * j] = o; }
    }
}
DI void ph_norm_mod(bf16* X, const float* g, const float* modL, int shoff, int scoff, bf16* H, int Mrows, const bf16* slab, int gw, int ngw, int lane) {
    NormLd A, B; int m = gw;
    if (m < Mrows) norm_issue(A, X, m, lane);
    for (; m < Mrows; m += 2 * ngw) { const int m2 = m + ngw, m3 = m2 + ngw;
        if (m2 < Mrows) norm_issue(B, X, m2, lane);
        norm_row(A, m, X, g, modL, shoff, scoff, H, slab, lane);
        if (m3 < Mrows) norm_issue(A, X, m3, lane);
        if (m2 < Mrows) norm_row(B, m2, X, g, modL, shoff, scoff, H, slab, lane);
    }
}
DI void unpack8(const v4u x, float (&f)[8]) { f[0] = bf_lo(x.x); f[1] = bf_hi(x.x); f[2] = bf_lo(x.y); f[3] = bf_hi(x.y); f[4] = bf_lo(x.z); f[5] = bf_hi(x.z); f[6] = bf_lo(x.w); f[7] = bf_hi(x.w); }
struct TokLd { v4u rq1, rq2, rk1, rk2; v2u rv; float b_raw, a_raw; f32x4 rp[4]; };
DI void tok_issue(TokLd& L, int m, const bf16* P, const float* PS, const float* ROPE, int offq, int offk, int a, int j4, int lane) {
    const RowInfo ri = row_info(m); const bf16* pr = P + (size_t)m * NINP;
    L.rq1 = __builtin_nontemporal_load((const v4u*)(pr + PC_GQ + offq)); L.rq2 = __builtin_nontemporal_load((const v4u*)(pr + PC_GQ + offq + 32));
    L.rk1 = __builtin_nontemporal_load((const v4u*)(pr + PC_GK + offk)); L.rk2 = __builtin_nontemporal_load((const v4u*)(pr + PC_GK + offk + 32));
    L.rv = __builtin_nontemporal_load((const v2u*)(pr + PC_GV + 4 * lane));
    L.b_raw = 0.f; L.a_raw = 0.f;
    if (lane < 8) { L.b_raw = PS[(size_t)m * 16 + lane]; L.a_raw = PS[(size_t)m * 16 + 8 + lane]; }
    const int pos = m < ML ? (a ? (ri.t & 63) : (ri.t >> 6)) : 0;
#pragma unroll
    for (int e = 0; e < 4; ++e) L.rp[e] = *(const f32x4*)(ROPE + (pos * 32 + 8 * j4 + 2 * e) * 2);
    asm volatile("" ::: "memory");
}
DI void tok_finish(const TokLd& L, int m, const f32x4 (&gl)[2][4], float nea, float dtb, float* LAB, bf16* QB, bf16* KB, bf16* VB, int offq, int offk, int lane) {
    const RowInfo ri = row_info(m); const bool lat = m < ML;
    if (lane < 8) { LAB[(size_t)m * 16 + lane] = nea * softplusf_(L.a_raw + dtb); LAB[(size_t)m * 16 + 8 + lane] = sigmoidf_(L.b_raw); }
    float cs_[8], sn_[8];
#pragma unroll
    for (int e = 0; e < 4; ++e) { cs_[2 * e] = L.rp[e].x; sn_[2 * e] = L.rp[e].y; cs_[2 * e + 1] = L.rp[e].z; sn_[2 * e + 1] = L.rp[e].w; }
    const int kvpos = lat ? ri.t : SEQ + ri.t;
#pragma unroll
    for (int part = 0; part < 2; ++part) {
        float x1[8], x2[8]; unpack8(part == 0 ? L.rq1 : L.rk1, x1); unpack8(part == 0 ? L.rq2 : L.rk2, x2);
        float ss = 0.f;
#pragma unroll
        for (int e = 0; e < 8; ++e) ss += x1[e] * x1[e] + x2[e] * x2[e];
        ss += __shfl_xor(ss, 1); ss += __shfl_xor(ss, 2); ss += __shfl_xor(ss, 4);
        const float rstd = __builtin_amdgcn_rsqf(ss * (1.0f / 128.0f) + EPS);
        const float g1[8] = {gl[part][0].x, gl[part][0].y, gl[part][0].z, gl[part][0].w, gl[part][1].x, gl[part][1].y, gl[part][1].z, gl[part][1].w};
        const float g2[8] = {gl[part][2].x, gl[part][2].y, gl[part][2].z, gl[part][2].w, gl[part][3].x, gl[part][3].y, gl[part][3].z, gl[part][3].w};
        float o1[8], o2[8];
        const float rs = part == 0 ? rstd * 0.12751743f : rstd;
#pragma unroll
        for (int e = 0; e < 8; ++e) { const float y1 = x1[e] * rs * g1[e], y2 = x2[e] * rs * g2[e]; o1[e] = y1 * cs_[e] - y2 * sn_[e]; o2[e] = y2 * cs_[e] + y1 * sn_[e]; }
        bf16* dst = part == 0 ? QB + (size_t)m * 1024 + offq : KB + ((size_t)ri.b * SKV + kvpos) * 256 + offk;
        if (part == 0 || lane < 16) { v4u w1, w2; w1.x = pk2(o1[0], o1[1]); w1.y = pk2(o1[2], o1[3]); w1.z = pk2(o1[4], o1[5]); w1.w = pk2(o1[6], o1[7]);
            w2.x = pk2(o2[0], o2[1]); w2.y = pk2(o2[2], o2[3]); w2.z = pk2(o2[4], o2[5]); w2.w = pk2(o2[6], o2[7]); *(v4u*)dst = w1; *(v4u*)(dst + 32) = w2; }
    }
    *(v2u*)(VB + ((size_t)ri.b * SKV + kvpos) * 256 + 4 * lane) = L.rv;
}
DI void ph_tokprep(const bf16* P, const float* PS, const float* gconv_w, const float* a_log, const float* dt_bias, const float* qg, const float* kg, const float* ROPE,
                   const float* lconv_w, const float* lconv_b, bf16* QKVC, float* LAB, bf16* QB, bf16* KB, bf16* VB, float* XC, int gw, int ngw, int lane) {
    constexpr int SEG = 34, NSEG = MT / SEG;
    static_assert(NSEG * SEG == MT, "segments");
    for (int it = gw; it < 4 * NSEG; it += ngw) {
        const int cs = it & 3, m0 = (it >> 2) * SEG;
        const bf16* pc = P + (cs < 3 ? PC_QKV + cs * 512 : PC_LX) + 8 * lane;
        const float* wsrc = cs < 3 ? gconv_w + cs * 512 + 8 * lane : lconv_w + 8 * lane; const int wstr = cs < 3 ? 1536 : 512;
        float w[4][8], bias[8];
#pragma unroll
        for (int j = 0; j < 4; ++j) { const f32x4 a = *(const f32x4*)(wsrc + j * wstr), b = *(const f32x4*)(wsrc + j * wstr + 4); w[j][0] = a.x; w[j][1] = a.y; w[j][2] = a.z; w[j][3] = a.w; w[j][4] = b.x; w[j][5] = b.y; w[j][6] = b.z; w[j][7] = b.w; }
#pragma unroll
        for (int e = 0; e < 8; ++e) bias[e] = cs == 3 ? lconv_b[8 * lane + e] : 0.f;
        const v4u z4 = {0u, 0u, 0u, 0u};
#define LDROW(row) (((row) >= 0 && (row) < MT) ? __builtin_nontemporal_load((const v4u*)(pc + (size_t)(row) * NINP)) : z4)
        v4u w0 = LDROW(m0 - 2), w1 = LDROW(m0 - 1), w2 = LDROW(m0), cur[8], nxt[8];
#pragma unroll
        for (int i = 0; i < 8; ++i) cur[i] = LDROW(m0 + 1 + i);
#pragma unroll 1
        for (int r0 = 0; r0 < SEG; r0 += 8) {
#pragma unroll
            for (int i = 0; i < 8; ++i) nxt[i] = (r0 + 8 + i < SEG) ? LDROW(m0 + r0 + 9 + i) : z4;
#pragma unroll
            for (int i = 0; i < 8; ++i) { if (r0 + i < SEG) { const int m = m0 + r0 + i; const RowInfo ri = row_info(m);
                const v4u w3 = cur[i];
                float acc[8], f[8];
#pragma unroll
                for (int e = 0; e < 8; ++e) acc[e] = bias[e];
                if (ri.t >= 2) { unpack8(w0, f);
#pragma unroll
                    for (int e = 0; e < 8; ++e) acc[e] += w[0][e] * f[e]; }
                if (ri.t >= 1) { unpack8(w1, f);
#pragma unroll
                    for (int e = 0; e < 8; ++e) acc[e] += w[1][e] * f[e]; }
                unpack8(w2, f);
#pragma unroll
                for (int e = 0; e < 8; ++e) acc[e] += w[2][e] * f[e];
                if (ri.t + 1 < ri.T) { unpack8(w3, f);
#pragma unroll
                    for (int e = 0; e < 8; ++e) acc[e] += w[3][e] * f[e]; }
                if (cs < 3) {
#pragma unroll
                    for (int e = 0; e < 8; ++e) acc[e] = siluf_(acc[e]);
                    if (cs < 2) { float ss = 0.f;
#pragma unroll
                        for (int e = 0; e < 8; ++e) ss += acc[e] * acc[e];
                        ss += __shfl_xor(ss, 1); ss += __shfl_xor(ss, 2); ss += __shfl_xor(ss, 4); ss += __shfl_xor(ss, 8);
                        float rn = __builtin_amdgcn_rsqf(ss + EPS); if (cs == 0) rn *= 0.08838834764831845f;
#pragma unroll
                        for (int e = 0; e < 8; ++e) acc[e] *= rn; }
                    v4u o; o.x = pk2(acc[0], acc[1]); o.y = pk2(acc[2], acc[3]); o.z = pk2(acc[4], acc[5]); o.w = pk2(acc[6], acc[7]);
                    *(v4u*)(QKVC + (size_t)m * 1536 + cs * 512 + 8 * lane) = o;
                } else { float* dst = XC + (size_t)m * 512 + 8 * lane;
                    *(f32x4*)dst = (f32x4){acc[0], acc[1], acc[2], acc[3]}; *(f32x4*)(dst + 4) = (f32x4){acc[4], acc[5], acc[6], acc[7]}; }
                w0 = w1; w1 = w2; w2 = w3; } }
#pragma unroll
            for (int i = 0; i < 8; ++i) cur[i] = nxt[i];
        }
#undef LDROW
    }
    { const int a = (lane >> 2) & 1, j4 = lane & 3;
      const int offq = (lane >> 3) * 128 + a * 64 + 8 * j4, offk = ((lane >> 3) & 1) * 128 + a * 64 + 8 * j4;
      f32x4 gl[2][4];
#pragma unroll
      for (int part = 0; part < 2; ++part) { const float* gn = (part == 0 ? qg : kg) + a * 64 + 8 * j4; gl[part][0] = *(const f32x4*)gn; gl[part][1] = *(const f32x4*)(gn + 4); gl[part][2] = *(const f32x4*)(gn + 32); gl[part][3] = *(const f32x4*)(gn + 36); }
      const float nea = -expf(a_log[lane & 7]), dtb = dt_bias[lane & 7];
      TokLd A, B; int m = gw;
      if (m < MT) tok_issue(A, m, P, PS, ROPE, offq, offk, a, j4, lane);
      for (; m < MT; m += 2 * ngw) { const int m2 = m + ngw, m3 = m2 + ngw;
          if (m2 < MT) tok_issue(B, m2, P, PS, ROPE, offq, offk, a, j4, lane);
          tok_finish(A, m, gl, nea, dtb, LAB, QB, KB, VB, offq, offk, lane);
          if (m3 < MT) tok_issue(A, m3, P, PS, ROPE, offq, offk, a, j4, lane);
          if (m2 < MT) tok_finish(B, m2, gl, nea, dtb, LAB, QB, KB, VB, offq, offk, lane);
      } }
}
DI void ph_small_cols(const bf16* H, const bf16* WIN, float* PS, int gw, int ngw, int lane) {
    const int r16 = lane & 15, q = lane >> 4;
    for (int tile = gw; tile < MT / 16; tile += ngw) {
        const bf16* ap = H + ((size_t)tile * 16 + r16) * DM + 8 * q; const bf16* bp = WIN + ((size_t)4608 + r16) * DM + 8 * q;
        f32x4 acc = {0.f, 0.f, 0.f, 0.f};
        for (int k0 = 0; k0 < DM / 32; k0 += 16) { bf16x8 a[16], b[16];
#pragma unroll
            for (int i = 0; i < 16; ++i) { a[i] = *(const bf16x8*)(ap + (k0 + i) * 32); b[i] = *(const bf16x8*)(bp + (k0 + i) * 32); }
#pragma unroll
            for (int i = 0; i < 16; ++i) acc = __builtin_amdgcn_mfma_f32_16x16x32_bf16(a[i], b[i], acc, 0, 0, 0); }
#pragma unroll
        for (int r = 0; r < 4; ++r) PS[((size_t)tile * 16 + 4 * q + r) * 16 + r16] = acc[r];
    }
}

struct GdnRegs { v4u qq[2], kq[2], vq[2]; float la, be; };
DI void gdn_issue(GdnRegs& R, int t2, const bf16* QKVC, const float* LAB, int tid) {
    const int h = t2 & 3, rb = (t2 >> 2) * 64; asm volatile("" : "+v"(tid));
#pragma unroll
    for (int e = 0; e < 2; ++e) { const int p = tid + 512 * e, a = p >> 4, c8 = (p & 15) * 8; const bf16* src = QKVC + (size_t)(rb + a) * 1536 + h * 128 + c8;
        R.qq[e] = __builtin_nontemporal_load((const v4u*)src); R.kq[e] = __builtin_nontemporal_load((const v4u*)(src + 512)); R.vq[e] = __builtin_nontemporal_load((const v4u*)(src + 1024)); }
    R.la = 0.f; R.be = 0.f;
    if (tid < 128) { const int d = tid >> 6, a = tid & 63; R.la = LAB[(size_t)(rb + a) * 16 + d * 4 + h]; R.be = LAB[(size_t)(rb + a) * 16 + 8 + d * 4 + h]; }
}
DI void gdn_chunk_task(int t2, int t2next, GdnRegs& R, const bf16* QKVC, const float* LAB, unsigned char* GT, float* GG, LAS unsigned char* lds, int tid) {
    const int h = t2 & 3, sc = t2 >> 2;
    const int wave = __builtin_amdgcn_readfirstlane(tid >> 6), lane = tid & 63, c32 = lane & 31, hf = lane >> 5;
    LAS unsigned char* Kb = lds;
    LAS unsigned char* Qb = lds + 17408;
    LAS unsigned char* KTb = lds + 34816;
    LAS unsigned char* VTb = lds + 53248;
    LAS float* Lt = (LAS float*)(lds + 71680);
    LAS unsigned char* TVW = lds + 104448;
    LAS float* laS = (LAS float*)(lds + 141312);
    LAS float* beS = laS + 128;
    LAS float* GS = beS + 128;
    unsigned char* gt0 = GT + (size_t)(t2 * 2) * GT_BYTES; unsigned char* gt1 = gt0 + GT_BYTES;
    gdn_issue(R, t2, QKVC, LAB, tid); (void)t2next;
    if (tid < 128) { laS[tid] = R.la; beS[tid] = R.be; }
    BAR_LDS();
    if (tid < 128) { const int d = tid >> 6, a = tid & 63; float g = 0.f;
        if (d == 0) { for (int j = 0; j <= a; ++j) g += laS[j]; } else { for (int j = a; j < 64; ++j) g += laS[64 + j]; }
        GS[tid] = g; }
    BAR_LDS();
    if (tid < 2) GG[t2 * 2 + tid] = expf(tid == 0 ? GS[63] : GS[64]);
#pragma unroll
    for (int e = 0; e < 2; ++e) { const int p = tid + 512 * e, a = p >> 4, c8 = (p & 15) * 8; const v4u kw = R.kq[e], qw = R.qq[e], vw = R.vq[e];
        *(LAS v4u*)(Kb + a * 272 + c8 * 2) = kw; *(LAS v4u*)(Qb + a * 272 + c8 * 2) = qw;
#pragma unroll
        for (int q = 0; q < 8; ++q) { *(LAS bf16*)(KTb + (c8 + q) * 144 + a * 2) = (bf16)(kw[q >> 1] >> (16 * (q & 1))); *(LAS bf16*)(VTb + (c8 + q) * 144 + a * 2) = (bf16)(vw[q >> 1] >> (16 * (q & 1))); }
        float qf[8]; unpack8(qw, qf);
#pragma unroll
        for (int d = 0; d < 2; ++d) { const float s_ = fexp_(GS[d * 64 + a]); const int ip = d ? 63 - a : a; unsigned char* qd = (d ? gt1 : gt0) + GT_QD + (size_t)ip * 256;
            v2u o0, o1; o0.x = pk2(qf[0] * s_, qf[1] * s_); o0.y = pk2(qf[2] * s_, qf[3] * s_); o1.x = pk2(qf[4] * s_, qf[5] * s_); o1.y = pk2(qf[6] * s_, qf[7] * s_);
            *(v2u*)(qd + gperm(c8) * 2) = o0; *(v2u*)(qd + gperm(c8 + 4) * 2) = o1; } }
    BAR_LDS();
    if (wave < 7) {
        const bool isqk = wave >= 3; const int ta = isqk ? ((wave - 3) >> 1) : (wave > 0 ? 1 : 0), tb = isqk ? ((wave - 3) & 1) : (wave > 1 ? 1 : 0);
        f32x16 acc;
#pragma unroll
        for (int r = 0; r < 16; ++r) acc[r] = 0.f;
        const LAS unsigned char* ap = (isqk ? Qb : Kb) + (32 * ta + c32) * 272 + hf * 16; const LAS unsigned char* bp = Kb + (32 * tb + c32) * 272 + hf * 16;
#pragma unroll
        for (int s = 0; s < 8; ++s) acc = __builtin_amdgcn_mfma_f32_32x32x16_bf16(*(const LAS bf16x8*)(ap + 32 * s), *(const LAS bf16x8*)(bp + 32 * s), acc, 0, 0, 0);
        const int bt = 32 * tb + c32; const float G0b = GS[bt], G1b = GS[64 + bt], be1b = beS[64 + bt];
#pragma unroll
        for (int r = 0; r < 16; ++r) { const int at = 32 * ta + crow32(r, hf); const float G0a = GS[at], G1a = GS[64 + at], c = acc[r];
            if (!isqk) { if (at > bt) { Lt[bt * 64 + at] = beS[at] * c * fexp_(G0a - G0b); Lt[4096 + (63 - at) * 64 + (63 - bt)] = be1b * c * fexp_(G1b - G1a); } }
            else { if (ta >= tb) ((bf16*)(gt0 + GT_AT))[at * 64 + gperm(bt)] = (bf16)f2bf(at >= bt ? c * fexp_(G0a - G0b) : 0.f);
                   if (ta <= tb) ((bf16*)(gt1 + GT_AT))[(63 - at) * 64 + gperm(63 - bt)] = (bf16)f2bf(at <= bt ? c * fexp_(G1a - G1b) : 0.f); } }
    }
    BAR_LDS();
    if (wave < 2) {
        const int d = wave, c = lane; float x[64];
        const LAS float* Lb = Lt + d * 4096; asm volatile("" : "+v"(Lb));
#pragma unroll
        for (int i = 0; i < 64; ++i) x[i] = (i == c) ? 1.f : 0.f;
#pragma unroll
        for (int j = 0; j < 63; ++j) { const float xj = x[j];
#pragma unroll
            for (int i4 = (j + 1) / 4; i4 < 16; ++i4) { const f32x4 l4 = *(const LAS f32x4*)(Lb + j * 64 + 4 * i4);
                if (4 * i4 + 0 > j) x[4 * i4 + 0] -= l4.x * xj; if (4 * i4 + 1 > j) x[4 * i4 + 1] -= l4.y * xj;
                if (4 * i4 + 2 > j) x[4 * i4 + 2] -= l4.z * xj; if (4 * i4 + 3 > j) x[4 * i4 + 3] -= l4.w * xj; }
            if ((j & 3) == 3) asm volatile("" ::: "memory"); }
        const int ac = d ? 63 - c : c; const float bc = beS[d * 64 + ac], bec = bc * fexp_(GS[d * 64 + ac]);
        LAS unsigned char* tv = TVW + (d * 2) * 9216 + ac * 2; asm volatile("" : "+v"(tv));
#pragma unroll
        for (int i = 0; i < 64; ++i) { *(LAS bf16*)(tv + i * 144) = (bf16)f2bf(x[i] * bc); *(LAS bf16*)(tv + 9216 + i * 144) = (bf16)f2bf(x[i] * bec); }
    } else {
        for (int it = tid - 128; it < 2048; it += 384) { const int d = it >> 10, dd = (it >> 3) & 127, g8 = it & 7, grp = g8 >> 1, hp = g8 & 1; const float glast = d ? GS[64] : GS[63];
            unsigned w[4];
#pragma unroll
            for (int t = 0; t < 8; t += 2) { const int i0 = 16 * grp + 8 * (t >> 2) + 4 * hp + (t & 3), a0 = d ? 63 - i0 : i0, a1 = d ? a0 - 1 : a0 + 1;
                const float k0 = __builtin_bit_cast(float, (unsigned)(*(const LAS bf16*)(KTb + dd * 144 + a0 * 2)) << 16), k1 = __builtin_bit_cast(float, (unsigned)(*(const LAS bf16*)(KTb + dd * 144 + a1 * 2)) << 16);
                w[t >> 1] = pk2(k0 * fexp_(glast - GS[d * 64 + a0]), k1 * fexp_(glast - GS[d * 64 + a1])); }
            v4u o; o.x = w[0]; o.y = w[1]; o.z = w[2]; o.w = w[3];
            *(v4u*)((d ? gt1 : gt0) + GT_KT + (size_t)(dd * 64 + 16 * grp + 8 * hp) * 2) = o; }
    }
    BAR_LDS();
    { const int mi = wave >> 1, d = mi >> 1, isw = mi & 1, it = wave & 1;
      const LAS unsigned char* ap = TVW + (d * 2 + isw) * 9216 + (32 * it + c32) * 144 + hf * 16; const LAS unsigned char* bp = (isw ? KTb : VTb) + c32 * 144 + hf * 16;
      bf16x8 af[4];
#pragma unroll
      for (int s = 0; s < 4; ++s) af[s] = *(const LAS bf16x8*)(ap + 32 * s);
      unsigned char* go = d ? gt1 : gt0;
#pragma unroll
      for (int ct = 0; ct < 4; ++ct) { f32x16 acc;
#pragma unroll
          for (int r = 0; r < 16; ++r) acc[r] = 0.f;
          if (isw) {
#pragma unroll
              for (int s = 0; s < 4; ++s) acc = __builtin_amdgcn_mfma_f32_32x32x16_bf16(af[s], *(const LAS bf16x8*)(bp + ct * 32 * 144 + 32 * s), acc, 0, 0, 0);
              bf16* wp = (bf16*)(go + GT_NW) + gperm(32 * ct + c32);
#pragma unroll
              for (int r = 0; r < 16; ++r) wp[(32 * it + crow32(r, hf)) * 128] = (bf16)f2bf(-acc[r]);
          } else {
#pragma unroll
              for (int s = 0; s < 4; ++s) acc = __builtin_amdgcn_mfma_f32_32x32x16_bf16(*(const LAS bf16x8*)(bp + ct * 32 * 144 + 32 * s), af[s], acc, 0, 0, 0);
              bf16* up = (bf16*)(go + GT_UT) + gperm(32 * it + c32);
#pragma unroll
              for (int r = 0; r < 16; ++r) up[(32 * ct + crow32(r, hf)) * 64] = (bf16)f2bf(acc[r]); } } }
    BAR_LDS();
}
DI void lru_chunk_item(int item, const float* XC, const bf16* GWT, const float* gate_b, const float* lam, bf16* LA, bf16* LU, float* LCT, LAS unsigned char* lds, int tid) {
    const int rt = item >> 3, n = item & 7, rb = rt * 64;
    const int wave = __builtin_amdgcn_readfirstlane(tid >> 6), lane = tid & 63, c32 = lane & 31, hf = lane >> 5;
    LAS float* xs = (LAS float*)lds;
    LAS unsigned char* xb = lds + 64 * 65 * 4;
    LAS float* as_ = (LAS float*)(lds + 64 * 65 * 4 + 64 * 144);
    LAS float* us = as_ + 2 * 64 * 64;
#pragma unroll
    for (int e = 0; e < 2; ++e) { const int idx = tid + 512 * e, r = idx >> 4, c4 = (idx & 15) * 4; const f32x4 v = __builtin_nontemporal_load((const f32x4*)(XC + (size_t)(rb + r) * 512 + n * 64 + c4));
        xs[r * 65 + c4] = v.x; xs[r * 65 + c4 + 1] = v.y; xs[r * 65 + c4 + 2] = v.z; xs[r * 65 + c4 + 3] = v.w;
        v2u w; w.x = pk2(v.x, v.y); w.y = pk2(v.z, v.w); *(LAS v2u*)(xb + r * 144 + c4 * 2) = w; }
    BAR_LDS();
    { const int dir = wave >> 2, half = (wave >> 1) & 1, rtile = wave & 1, e = 32 * half + c32, ch = n * 64 + e;
      f32x16 acc0, acc1;
#pragma unroll
      for (int r = 0; r < 16; ++r) { acc0[r] = 0.f; acc1[r] = 0.f; }
      const bf16* b0p = GWT + ((size_t)((dir * 2 + 0) * 8 + n) * 64 + e) * 64 + 8 * hf; const bf16* b1p = GWT + ((size_t)((dir * 2 + 1) * 8 + n) * 64 + e) * 64 + 8 * hf;
      bf16x8 bw0[4], bw1[4];
#pragma unroll
      for (int s = 0; s < 4; ++s) { bw0[s] = *(const bf16x8*)(b0p + 16 * s); bw1[s] = *(const bf16x8*)(b1p + 16 * s); }
#pragma unroll
      for (int s = 0; s < 4; ++s) { const bf16x8 a = *(const LAS bf16x8*)(xb + (32 * rtile + c32) * 144 + (16 * s + 8 * hf) * 2);
          acc0 = __builtin_amdgcn_mfma_f32_32x32x16_bf16(a, bw0[s], acc0, 0, 0, 0);
          acc1 = __builtin_amdgcn_mfma_f32_32x32x16_bf16(a, bw1[s], acc1, 0, 0, 0); }
      const float gb0 = gate_b[(dir * 2 + 0) * 512 + ch], gb1 = gate_b[(dir * 2 + 1) * 512 + ch], spl = softplusf_(-lam[dir * 512 + ch]);
#pragma unroll
      for (int r = 0; r < 16; ++r) { const int row = 32 * rtile + crow32(r, hf); const float xv = xs[row * 65 + e];
          const float rgt = sigmoidf_(acc0[r] + gb0), igt = sigmoidf_(acc1[r] + gb1); const float a = fexp_(-8.0f * rgt * spl);
          as_[(dir * 64 + row) * 64 + e] = a; us[(dir * 64 + row) * 64 + e] = sqrtf(fmaxf(1.0f - a * a, 0.f)) * (igt * xv); } }
    BAR_LDS();
    if (wave < 2) { const int dir = wave, e = lane, ch = n * 64 + e; float hl = 0.f, cp = 1.f;
        const LAS float* ap = as_ + dir * 4096 + e; const LAS float* up = us + dir * 4096 + e; const size_t ob = ((size_t)dir * MT + rb) * 512 + ch;
#pragma unroll 16
        for (int i = 0; i < 64; ++i) { const int r = dir ? 63 - i : i; const float a = ap[r * 64], u = up[r * 64]; hl = a * hl + u; cp *= a; __builtin_nontemporal_store((bf16)f2bf(hl), LU + ob + (size_t)r * 512); __builtin_nontemporal_store((bf16)f2bf(cp), LA + ob + (size_t)r * 512); }
        float* ct = LCT + (((size_t)dir * NCHUNK + rt) * 512 + ch) * 2; ct[0] = cp; ct[1] = hl; }
    BAR_LDS();
}
template <bool ALLOW_FIXED>
DI void ph_attention(const bf16* QB, const bf16* KB, const bf16* VB, bf16* Y, int u0, int nunits, char* lds, int ustride, const float* qg, const float* kg) {
    bool fixed = false;
    if constexpr (ALLOW_FIXED) { int t_ = threadIdx.x; asm volatile("" : "+v"(t_)); const int lane = t_ & 63;
        float mq = fmaxf(fabsf(qg[lane]), fabsf(qg[64 + lane])), mk = fmaxf(fabsf(kg[lane]), fabsf(kg[64 + lane]));
#pragma unroll
        for (int o = 1; o < 64; o <<= 1) { mq = fmaxf(mq, __shfl_xor(mq, o)); mk = fmaxf(mk, __shfl_xor(mk, o)); }
        const float B = 11.313708499f * 1.02f * mq * mk;
        fixed = __builtin_amdgcn_readfirstlane((int)(B <= 40.f)) != 0; }
    for (int u = u0; u < nunits; u += ustride) {
        size_t qrow, kvrow; int hq, kvh, seq;
        if (u < 512) { const int grp = u & 7, idx = u >> 3, b = grp >> 1; kvh = grp & 1; hq = kvh * 4 + (idx >> 4); qrow = (size_t)b * SEQ + (idx & 15) * 256; kvrow = (size_t)b * SKV; seq = SKV; }
        else { const int v = u - 512, b = v >> 3; hq = v & 7; kvh = hq >> 2; qrow = (size_t)ML + b * CTXL; kvrow = (size_t)b * SKV + SEQ; seq = CTXL; }
        __syncthreads();
        if (ALLOW_FIXED && fixed) att::attn_dense_body<att::bf16, true>((const att::bf16*)(QB + qrow * 1024 + hq * 128), (const att::bf16*)(KB + kvrow * 256 + kvh * 128), (const att::bf16*)(VB + kvrow * 256 + kvh * 128), Y + qrow * DM + 512 + hq * 128, seq, lds);
        else att::attn_dense_body<att::bf16, false>((const att::bf16*)(QB + qrow * 1024 + hq * 128), (const att::bf16*)(KB + kvrow * 256 + kvh * 128), (const att::bf16*)(VB + kvrow * 256 + kvh * 128), Y + qrow * DM + 512 + hq * 128, seq, lds);
    }
}
DI void ph_lru_carry(const float* LCT, float* LCI, int bid, int tid) {
    const int gid = bid * 512 + tid; if (gid >= 4096) return;
    const int b = gid >> 10, dir = (gid >> 9) & 1, ch = gid & 511; float c = 0.f;
    for (int k0 = 0; k0 < 68; k0 += 34) {
        f32x2 t[34]; int kk = k0; asm volatile("" : "+v"(kk));
#pragma unroll
        for (int k = 0; k < 34; ++k) { const int sc = chain_chunk(b, dir, kk + k); t[k] = *(const f32x2*)(LCT + (((size_t)dir * NCHUNK + sc) * 512 + ch) * 2); }
#pragma unroll
        for (int k = 0; k < 34; ++k) { const int sc = chain_chunk(b, dir, kk + k); LCI[((size_t)dir * NCHUNK + sc) * 512 + ch] = c; c = t[k].x * c + t[k].y; }
    }
}
constexpr int SC_NW = 0, SC_QD = 17408, SC_KT = 34816, SC_AT = 53248, SC_UT = 62464, SC_DEC = 80896, SC_BUF = 80960;
static_assert(2 * SC_BUF <= PH_LDS, "scan LDS");
struct ScanRegs { v4u p[18]; float dec; };
DI void scan_issue(ScanRegs& R, const unsigned char* gt, const float* decp, int lt) {
    asm volatile("" : "+v"(lt));
#pragma unroll
    for (int e = 0; e < 18; ++e) R.p[e] = __builtin_nontemporal_load((const v4u*)(gt + (size_t)(lt + 256 * e) * 16));
    R.dec = *decp;
}
DI void scan_write(const ScanRegs& R, LAS unsigned char* buf, int lt) {
    asm volatile("" : "+v"(lt));
#pragma unroll
    for (int e = 0; e < 18; ++e) { const int p = lt + 256 * e;
        int off; if (e < 8) { const int q = p & 1023; off = (e < 4 ? SC_NW : SC_QD) + (q >> 4) * 272 + (q & 15) * 16; }
        else if (e < 12) { const int q = p - 2048; off = SC_KT + (q >> 3) * 144 + (q & 7) * 16; }
        else if (e < 14) { const int q = p - 3072; off = SC_AT + (q >> 3) * 144 + (q & 7) * 16; }
        else { const int q = p - 3584; off = SC_UT + (q >> 3) * 144 + (q & 7) * 16; }
        *(LAS v4u*)(buf + off) = R.p[e]; }
    if (lt == 0) *(LAS float*)(buf + SC_DEC) = R.dec;
}
template <int D> DI void gdn_scan_chain_d(int chain, const unsigned char* GT, const float* GG, bf16* OF, bf16* OB, LAS unsigned char* lds, int tid) {
    const int b = chain >> 3, hd = (chain >> 1) & 3; constexpr int d = D;
    const int wave = __builtin_amdgcn_readfirstlane(tid >> 6), lane = tid & 63, c32 = lane & 31, hf = lane >> 5;
    bf16* Od = d ? OB : OF;
#define SCAN_BAR() do { asm volatile("s_waitcnt lgkmcnt(0)" ::: "memory"); __builtin_amdgcn_s_barrier(); asm volatile("" ::: "memory"); } while (0)
#define TASK_OF(k) ((size_t)((chain_chunk(b, d, (k)) * 4 + hd) * 2 + d))
    if (wave >= 4) {
        const int lt = tid - 256; ScanRegs R0, R1;
        scan_issue(R0, GT + TASK_OF(0) * GT_BYTES, GG + TASK_OF(0), lt); scan_issue(R1, GT + TASK_OF(1) * GT_BYTES, GG + TASK_OF(1), lt);
        scan_write(R0, lds, lt); scan_issue(R0, GT + TASK_OF(2) * GT_BYTES, GG + TASK_OF(2), lt);
        SCAN_BAR();
        for (int k = 0; k < 68; k += 2) {
            scan_write(R1, lds + SC_BUF, lt); if (k + 3 < 68) scan_issue(R1, GT + TASK_OF(k + 3) * GT_BYTES, GG + TASK_OF(k + 3), lt);
            SCAN_BAR();
            if (k + 2 < 68) scan_write(R0, lds, lt); if (k + 4 < 68) scan_issue(R0, GT + TASK_OF(k + 4) * GT_BYTES, GG + TASK_OF(k + 4), lt);
            SCAN_BAR();
        }
    } else {
        const int ws = wave; f32x16 S[4], vacc[2];
#pragma unroll
        for (int t = 0; t < 4; ++t)
#pragma unroll
            for (int r = 0; r < 16; ++r) S[t][r] = 0.f;
        bf16x8 If[2];
#pragma unroll
        for (int s = 0; s < 2; ++s)
#pragma unroll
            for (int j = 0; j < 8; ++j) If[s][j] = (c32 == 16 * s + 8 * (j >> 2) + 4 * hf + (j & 3)) ? (short)0x3F80 : (short)0;
        SCAN_BAR();
        const int aoff = c32 * 272 + hf * 16, koff = c32 * 144 + hf * 16;
#define SB() __builtin_amdgcn_sched_barrier(0)
#define LD_ROW(F, base, it_, tp_) do { _Pragma("unroll") for (int i_ = 0; i_ < 4; ++i_) F[i_] = *(const LAS bf16x8*)(buf + (base) + aoff + (it_) * 32 * 272 + (32 * (2 * (tp_) + (i_ >> 1)) + 16 * (i_ & 1)) * 2); } while (0)
#define MM_ROW(F, acc, tp_) do { _Pragma("unroll") for (int i_ = 0; i_ < 4; ++i_) acc = __builtin_amdgcn_mfma_f32_32x32x16_bf16(F[i_], Sp[2 * (tp_) + (i_ >> 1)][i_ & 1], acc, 0, 0, 0); } while (0)
#define LD_AT(F, it_, n_) do { _Pragma("unroll") for (int i_ = 0; i_ < (n_); ++i_) F[i_] = *(const LAS bf16x8*)(buf + SC_AT + koff + (it_) * 32 * 144 + (32 * (i_ >> 1) + 16 * (i_ & 1)) * 2); } while (0)
#define MM_AT(F, acc, n_) do { _Pragma("unroll") for (int i_ = 0; i_ < (n_); ++i_) acc = __builtin_amdgcn_mfma_f32_32x32x16_bf16(F[i_], vp[i_ >> 1][i_ & 1], acc, 0, 0, 0); } while (0)
#define LD_KT(F, t_) do { _Pragma("unroll") for (int i_ = 0; i_ < 4; ++i_) F[i_] = *(const LAS bf16x8*)(buf + SC_KT + koff + (t_) * 32 * 144 + (32 * (i_ >> 1) + 16 * (i_ & 1)) * 2); } while (0)
#define MM_KT(F, t_) do { _Pragma("unroll") for (int i_ = 0; i_ < 4; ++i_) S[t_] = __builtin_amdgcn_mfma_f32_32x32x16_bf16(F[i_], vp[i_ >> 1][i_ & 1], S[t_], 0, 0, 0); } while (0)
#define ST_O(o, it_) do { const int i0 = 32 * (it_) + 4 * hfo; bf16* ob = Od + ((size_t)sc * 64 + (d ? 63 - i0 : i0)) * 512 + hd * 128 + 32 * ws + c32; \
        _Pragma("unroll") for (int r = 0; r < 16; r += 2) { const unsigned w2 = pk2(o[r], o[r + 1]); const int dr = (r & 3) + 8 * (r >> 2); \
            __builtin_nontemporal_store((bf16)w2, ob + (d ? -dr : dr) * 512); __builtin_nontemporal_store((bf16)(w2 >> 16), ob + (d ? -(dr + 1) : dr + 1) * 512); } } while (0)
        for (int k = 0; k < 68; ++k) {
            const LAS unsigned char* buf = lds + (k & 1) * SC_BUF; const int sc = chain_chunk(b, d, k); const size_t tk = (size_t)((sc * 4 + hd) * 2 + d);
            const float dec = *(const LAS float*)(buf + SC_DEC);
            int hfo = hf; asm volatile("" : "+v"(hfo));
            bf16x8 Sp[4][2], vp[2][2], F0[4], F1[4]; f32x16 o;
#pragma unroll
            for (int t = 0; t < 4; ++t) { Sp[t][0] = pack_acc(S[t], 0); Sp[t][1] = pack_acc(S[t], 1); }
            { const LAS unsigned char* up = buf + SC_UT + (32 * ws + c32) * 144 + hf * 16;
#pragma unroll
              for (int i_ = 0; i_ < 4; ++i_) F1[i_] = *(const LAS bf16x8*)(up + (32 * (i_ >> 1) + 16 * (i_ & 1)) * 2); }
            LD_ROW(F0, SC_NW, 0, 0); SB();
#pragma unroll
            for (int it = 0; it < 2; ++it) {
#pragma unroll
                for (int r = 0; r < 16; ++r) vacc[it][r] = 0.f;
                vacc[it] = __builtin_amdgcn_mfma_f32_32x32x16_bf16(If[0], F1[2 * it], vacc[it], 0, 0, 0); vacc[it] = __builtin_amdgcn_mfma_f32_32x32x16_bf16(If[1], F1[2 * it + 1], vacc[it], 0, 0, 0); }
            SB();
            LD_ROW(F1, SC_NW, 0, 1); SB(); MM_ROW(F0, vacc[0], 0); SB();
            LD_ROW(F0, SC_NW, 1, 0); SB(); MM_ROW(F1, vacc[0], 1); SB();
            LD_ROW(F1, SC_NW, 1, 1); SB(); MM_ROW(F0, vacc[1], 0); SB();
            LD_ROW(F0, SC_QD, 0, 0); SB(); MM_ROW(F1, vacc[1], 1); SB();
            vp[0][0] = pack_acc(vacc[0], 0); vp[0][1] = pack_acc(vacc[0], 1); vp[1][0] = pack_acc(vacc[1], 0); vp[1][1] = pack_acc(vacc[1], 1); SB();
#pragma unroll
            for (int r = 0; r < 16; ++r) o[r] = 0.f;
            LD_ROW(F1, SC_QD, 0, 1); SB(); MM_ROW(F0, o, 0); SB();
            LD_AT(F0, 0, 2); SB(); MM_ROW(F1, o, 1); SB();
            LD_ROW(F1, SC_QD, 1, 0); SB(); MM_AT(F0, o, 2); SB();
            ST_O(o, 0); SB();
#pragma unroll
            for (int r = 0; r < 16; ++r) o[r] = 0.f;
            LD_ROW(F0, SC_QD, 1, 1); SB(); MM_ROW(F1, o, 0); SB();
            LD_AT(F1, 1, 4); SB(); MM_ROW(F0, o, 1); SB();
            LD_KT(F0, 0); SB(); MM_AT(F1, o, 4); SB();
            ST_O(o, 1); SB();
#pragma unroll
            for (int t = 0; t < 4; ++t) S[t] = S[t] * dec;
            LD_KT(F1, 1); SB(); MM_KT(F0, 0); SB();
            LD_KT(F0, 2); SB(); MM_KT(F1, 1); SB();
            LD_KT(F1, 3); SB(); MM_KT(F0, 2); SB();
            MM_KT(F1, 3); SB();
            SCAN_BAR();
        }
#undef SB
#undef LD_ROW
#undef MM_ROW
#undef LD_AT
#undef MM_AT
#undef LD_KT
#undef MM_KT
#undef ST_O
    }
#undef TASK_OF
#undef SCAN_BAR
}
DI void gdn_scan_chain(int chain, const unsigned char* GT, const float* GG, bf16* OF, bf16* OB, LAS unsigned char* lds, int tid) {
    if (chain & 1) gdn_scan_chain_d<1>(chain, GT, GG, OF, OB, lds, tid); else gdn_scan_chain_d<0>(chain, GT, GG, OF, OB, lds, tid);
}
struct PostLd { v4u of, ob, z, hf, af, hb, ab, gt; f32x4 cf0, cf1, cb0, cb1; };
DI void post_issue(PostLd& L, int m, const bf16* P, const bf16* OF, const bf16* OB, const bf16* LA, const bf16* LU, const float* LCI, int col) {
    const int sc = m >> 6; const size_t o0 = (size_t)m * 512 + col, o1 = ((size_t)MT + m) * 512 + col;
    L.of = __builtin_nontemporal_load((const v4u*)(OF + o0)); L.ob = __builtin_nontemporal_load((const v4u*)(OB + o0)); L.z = *(const v4u*)(P + (size_t)m * NINP + PC_Z + col);
    L.hf = __builtin_nontemporal_load((const v4u*)(LU + o0)); L.af = __builtin_nontemporal_load((const v4u*)(LA + o0)); L.hb = __builtin_nontemporal_load((const v4u*)(LU + o1)); L.ab = __builtin_nontemporal_load((const v4u*)(LA + o1));
    L.gt = *(const v4u*)(P + (size_t)m * NINP + PC_LG + col);
    L.cf0 = *(const f32x4*)(LCI + (size_t)sc * 512 + col); L.cf1 = *(const f32x4*)(LCI + (size_t)sc * 512 + col + 4); L.cb0 = *(const f32x4*)(LCI + ((size_t)NCHUNK + sc) * 512 + col); L.cb1 = *(const f32x4*)(LCI + ((size_t)NCHUNK + sc) * 512 + col + 4);
    asm volatile("" ::: "memory");
}
DI void post_finish(const PostLd& L, int m, const f32x4 g0, const f32x4 g1, bf16* Y, int col) {
    { float of[8], ob[8], o[8], z[8]; float ss = 0.f;
      unpack8(L.of, of); unpack8(L.ob, ob); unpack8(L.z, z);
#pragma unroll
      for (int e = 0; e < 8; ++e) { o[e] = of[e] + ob[e]; ss += o[e] * o[e]; }
      ss += __shfl_xor(ss, 1); ss += __shfl_xor(ss, 2); ss += __shfl_xor(ss, 4); ss += __shfl_xor(ss, 8);
      const float rstd = 1.0f / sqrtf(ss * (1.0f / 128.0f) + EPS);
      const float g[8] = {g0.x, g0.y, g0.z, g0.w, g1.x, g1.y, g1.z, g1.w}; float y[8];
#pragma unroll
      for (int e = 0; e < 8; ++e) y[e] = o[e] * rstd * g[e] * siluf_(z[e]);
      v4u w; w.x = pk2(y[0], y[1]); w.y = pk2(y[2], y[3]); w.z = pk2(y[4], y[5]); w.w = pk2(y[6], y[7]);
      *(v4u*)(Y + (size_t)m * DM + col) = w; }
    { float hf[8], af[8], hb[8], ab[8], gt[8], y[8];
      unpack8(L.hf, hf); unpack8(L.af, af); unpack8(L.hb, hb); unpack8(L.ab, ab); unpack8(L.gt, gt);
      const float cf[8] = {L.cf0.x, L.cf0.y, L.cf0.z, L.cf0.w, L.cf1.x, L.cf1.y, L.cf1.z, L.cf1.w}, cb[8] = {L.cb0.x, L.cb0.y, L.cb0.z, L.cb0.w, L.cb1.x, L.cb1.y, L.cb1.z, L.cb1.w};
#pragma unroll
      for (int e = 0; e < 8; ++e) y[e] = gelu_tanhf_(gt[e]) * ((hf[e] + af[e] * cf[e]) + (hb[e] + ab[e] * cb[e]));
      v4u w; w.x = pk2(y[0], y[1]); w.y = pk2(y[2], y[3]); w.z = pk2(y[4], y[5]); w.w = pk2(y[6], y[7]);
      *(v4u*)(Y + (size_t)m * DM + 1536 + col) = w; }
}
DI void ph_post(const bf16* P, const bf16* OF, const bf16* OB, const float* gn, const bf16* LA, const bf16* LU, const float* LCI, bf16* Y, int Mrows, int gw, int ngw, int lane) {
    const int col = 8 * lane;
    const f32x4 g0 = *(const f32x4*)(gn + (col & 127)), g1 = *(const f32x4*)(gn + (col & 127) + 4);
    PostLd A, B; int m = gw;
    if (m < Mrows) post_issue(A, m, P, OF, OB, LA, LU, LCI, col);
    for (; m < Mrows; m += 2 * ngw) { const int m2 = m + ngw, m3 = m2 + ngw;
        if (m2 < Mrows) post_issue(B, m2, P, OF, OB, LA, LU, LCI, col);
        post_finish(A, m, g0, g1, Y, col);
        if (m3 < Mrows) post_issue(A, m3, P, OF, OB, LA, LU, LCI, col);
        if (m2 < Mrows) post_finish(B, m2, g0, g1, Y, col);
    }
}
DI void ph_convfix(const float* RAW, const float* cw, const float* cb, bf16* A, int npanels, int bid, int G, int tid) {
    const int total = npanels * 2 * (FF / 8);
    for (int idx = bid * 512 + tid; idx < total; idx += G * 512) {
        const int pe = idx / (FF / 8), j = (idx - pe * (FF / 8)) * 8, pm = pe >> 1, bot = pe & 1, row = pm * 256 + (bot ? 255 : 0); const RowInfo ri = row_info(row);
        const float* rc = RAW + ((size_t)pm * 4 + (bot ? 3 : 0)) * FF2 + j;
        const float* rp = bot ? rc - FF2 : rc - FF2;
        const float* rn = bot ? rc + FF2 : rc + FF2;
        const bool hp = ri.t > 0, hn = ri.t + 1 < ri.T;
        float r[2][8];
#pragma unroll
        for (int half = 0; half < 2; ++half) { const int o = half * FF;
            f32x4 a0 = *(const f32x4*)(cb + o + j), a1 = *(const f32x4*)(cb + o + j + 4);
#pragma unroll
            for (int tap = 0; tap < 3; ++tap) { const float* src = tap == 0 ? rp : (tap == 1 ? rc : rn); const bool ok = tap == 0 ? hp : (tap == 1 ? true : hn);
                if (ok) { a0 += *(const f32x4*)(cw + tap * FF2 + o + j) * *(const f32x4*)(src + o); a1 += *(const f32x4*)(cw + tap * FF2 + o + j + 4) * *(const f32x4*)(src + o + 4); } }
            r[half][0] = a0.x; r[half][1] = a0.y; r[half][2] = a0.z; r[half][3] = a0.w; r[half][4] = a1.x; r[half][5] = a1.y; r[half][6] = a1.z; r[half][7] = a1.w; }
        v4u w; w.x = pk2(siluf_(r[0][0]) * r[1][0], siluf_(r[0][1]) * r[1][1]); w.y = pk2(siluf_(r[0][2]) * r[1][2], siluf_(r[0][3]) * r[1][3]);
        w.z = pk2(siluf_(r[0][4]) * r[1][4], siluf_(r[0][5]) * r[1][5]); w.w = pk2(siluf_(r[0][6]) * r[1][6], siluf_(r[0][7]) * r[1][7]);
        *(v4u*)(A + (size_t)row * FF + j) = w;
    }
}
DI void ph_final_norm(const bf16* X, const float* g, float* out, int gw, int ngw, int lane) {
    for (int m = gw; m < ML; m += ngw) {
        const v4u* xr = (const v4u*)(X + (size_t)m * DM) + lane; v4u xb[4]; f32x4 v[8]; float ss = 0.f;
#pragma unroll
        for (int j = 0; j < 4; ++j) xb[j] = xr[64 * j];
#pragma unroll
        for (int j = 0; j < 4; ++j) { v[2 * j] = (f32x4){bf_lo(xb[j].x), bf_hi(xb[j].x), bf_lo(xb[j].y), bf_hi(xb[j].y)}; v[2 * j + 1] = (f32x4){bf_lo(xb[j].z), bf_hi(xb[j].z), bf_lo(xb[j].w), bf_hi(xb[j].w)}; }
#pragma unroll
        for (int j = 0; j < 8; ++j) ss += (v[j].x * v[j].x + v[j].y * v[j].y) + (v[j].z * v[j].z + v[j].w * v[j].w);
        const float rstd = 1.0f / sqrtf(wave_sum(ss) * (1.0f / DM) + EPS);
        f32x4* orow = (f32x4*)(out + (size_t)m * DM) + 2 * lane;
        f32x4 gg[8];
#pragma unroll
        for (int j = 0; j < 8; ++j) gg[j] = *(const f32x4*)(g + 512 * (j >> 1) + 8 * lane + 4 * (j & 1));
#pragma unroll
        for (int j = 0; j < 8; ++j) orow[128 * (j >> 1) + (j & 1)] = v[j] * rstd * gg[j];
    }
}

#ifndef MK_ONE_LAUNCH
#define MK_ONE_LAUNCH 1
#endif
#ifndef TESTSEL
#define TESTSEL 0
#endif
#ifndef PH_MASK
#define PH_MASK 0xFFFFFFFFu
#endif
#define PHEN(j) (((PH_MASK) >> (j)) & 1u)
#ifndef DUP_PH
#define DUP_PH -1
#endif
#ifndef DUP_SUB
#define DUP_SUB 0
#endif
#define REP(j) for (int rep_ = 0; rep_ < ((DUP_PH) == (j) ? 2 : 1); ++rep_)
constexpr int NPH = 2 + 12 * DEPTH + 1;
struct Args { const float* in[26]; float* out; unsigned char* ws; int ph_lo, ph_hi; };
typedef __attribute__((address_space(4))) Args KArgs;
__global__ void __launch_bounds__(512, 2) fwd_kernel(Args args) {
    extern __shared__ __attribute__((aligned(16))) unsigned char lds_raw[];
    LAS unsigned char* lds = (LAS unsigned char*)lds_raw;
    volatile LAS unsigned* MISC = (volatile LAS unsigned*)(lds + MISC_OFF);
    const int G0 = gridDim.x, bid = blockIdx.x;
    const int lo = args.ph_lo, hi = args.ph_hi;
    for (int u = threadIdx.x; u < 64; u += 512) MISC[u] = 0u;
    __syncthreads();
    XcdBarrier bar;
    { unsigned* bw = (unsigned*)(args.ws + WS_CTL) + CW_BAR; bar.bar = bw; bar.x = 0; bar.st = nullptr; if (hi - lo > 1) bar = xcd_barrier_post(bw, MISC + 8); }
#define IN(k) (lo <= (k) && (k) < hi)
#ifndef DUP_BAR
#define DUP_BAR 0
#endif
#define SEAM(k) do { if (IN(k) && IN((k) + 1)) { xcd_barrier(bar); if (DUP_BAR) xcd_barrier(bar); } } while (0)
#define WSL() int tid = threadIdx.x; asm volatile("" : "+v"(tid)); int G = G0; asm volatile("" : "+s"(G)); const int ngw = G * 8; (void)ngw; const int lane = tid & 63, wave = __builtin_amdgcn_readfirstlane(tid >> 6), gw = bid * 8 + wave; (void)lane; (void)gw; GAS unsigned char* ws = (GAS unsigned char*)args.ws; asm volatile("" : "+s"(ws)); const KArgs* ka = (const KArgs*)__builtin_amdgcn_kernarg_segment_ptr(); asm volatile("" : "+s"(ka))
#define INP(k) ((const float*)((const GAS float*)ka->in[k]))
#define W_(type, off) ((type*)((GAS type*)(ws + (off))))

    if (PHEN(0) && IN(0)) { WSL(); ph_prologue_a(INP(0), INP(2), INP(1), INP(3), INP(4), W_(bf16, WS_X), W_(float, WS_ROPE), W_(float, WS_MODP), lds, bid, G, tid);
        __syncthreads(); ph_wconv(INP(8), INP(20), INP(21), INP(24), INP(17), W_(bf16, WS_WIN), W_(bf16, WS_WOUT), W_(bf16, WS_WUP), W_(bf16, WS_WDN), W_(bf16, WS_GWT), lds, gw, ngw, wave, lane); SEAM(0); }
    if (PHEN(1) && IN(1)) { WSL(); ph_prologue_b(INP(5), W_(float, WS_MODP), W_(float, WS_MOD), bid, G, tid); SEAM(1); }
    for (int L = 0; L < DEPTH; ++L) {
        const int pb = 2 + 12 * L;
        if (pb + 12 <= lo || pb >= hi) continue;
        const bool ctx_out = L < DEPTH - 1; const int Mrows = ctx_out ? MT : ML;
        const size_t wset = (L & 1) ? (WS_WSET1 - WS_WIN) : 0;
        if (PHEN(2) && IN(pb + 0)) { REP(2) { WSL();
            ph_norm_mod(W_(bf16, WS_X), INP(6) + L * DM, W_(float, WS_MOD) + (size_t)L * 5 * NMODV, 0, DM, W_(bf16, WS_H), MT, (L > 0 && G == 256) ? W_(bf16, WS_SLAB) : nullptr, gw, ngw, lane);
            }
            SEAM(pb + 0); }
        if (PHEN(3) && IN(pb + 1)) { REP(3) { WSL();
            pg8::Gemm g{W_(bf16, WS_H), W_(bf16, WS_WIN + wset), MT, 4608, DM}; pg8::StaticOrder S; S.init(MT, 4608, G, bid, DM); pg8::EpiStoreBf16 E{W_(bf16, WS_P), NINP};
            pg8::gemm_phase<pg8::EpiStoreBf16, pg8::StaticOrder, true, true>(lds, g, S, E);
            ph_small_cols(W_(bf16, WS_H), W_(bf16, WS_WIN + wset), W_(float, WS_PS), gw, ngw, lane);
            }
            SEAM(pb + 1); }
        if (PHEN(4) && IN(pb + 2)) { REP(4) { WSL();
            ph_tokprep(W_(bf16, WS_P), W_(float, WS_PS), INP(9) + (size_t)L * 4 * 1536, INP(10) + L * 8, INP(11) + L * 8, INP(13) + L * 128, INP(14) + L * 128, W_(float, WS_ROPE),
                       INP(15) + (size_t)L * 4 * 512, INP(16) + L * 512, W_(bf16, WS_QKVC), W_(float, WS_LAB), W_(bf16, WS_QB), W_(bf16, WS_KB), W_(bf16, WS_VB), W_(float, WS_XC), gw, ngw, lane);
            }
            SEAM(pb + 2); }
        if (PHEN(5) && IN(pb + 3)) { REP(5) { WSL();
            if (TESTSEL != 2 && !(rep_ == 1 && DUP_SUB == 2)) { GdnRegs GR;
                for (int it = bid; it < NGTASK / 2; it += G) { int t2 = tid; asm volatile("" : "+v"(t2));
                    gdn_chunk_task(it, it + G < NGTASK / 2 ? it + G : -1, GR, W_(bf16, WS_QKVC), W_(float, WS_LAB), W_(unsigned char, WS_GT), W_(float, WS_GG), lds, t2); } }
            const bool bal = (G == 256); const int li0 = bal ? (bid >= 64 ? bid - 64 : NGTASK) : bid, lis = bal ? 192 : G, lie = bal ? 576 : NGTASK;
            if (TESTSEL != 1 && !(rep_ == 1 && DUP_SUB == 1)) for (int it = li0; it < lie; it += lis) { int t2 = tid; asm volatile("" : "+v"(t2));
                lru_chunk_item(it, W_(float, WS_XC), W_(bf16, WS_GWT + wset), INP(18) + L * 2 * 2 * 512, INP(19) + L * 2 * 512, W_(bf16, WS_LA), W_(bf16, WS_LU), W_(float, WS_LCT), lds, t2); }
            }
            SEAM(pb + 3); }
        if (PHEN(7) && IN(pb + 4)) { REP(7) { WSL();
            if (bid < 32) { if (!(rep_ == 1 && DUP_SUB == 2)) { __syncthreads(); gdn_scan_chain(bid, W_(unsigned char, WS_GT), W_(float, WS_GG), W_(bf16, WS_OF), W_(bf16, WS_OB), lds, tid); } }
            else if (bid >= 40 && !(rep_ == 1 && DUP_SUB == 1)) {
                if (G == 256) for (int it = 576 + bid - 40; it < NGTASK; it += 216) { int t2 = tid; asm volatile("" : "+v"(t2));
                    lru_chunk_item(it, W_(float, WS_XC), W_(bf16, WS_GWT + wset), INP(18) + L * 2 * 2 * 512, INP(19) + L * 2 * 512, W_(bf16, WS_LA), W_(bf16, WS_LU), W_(float, WS_LCT), lds, t2); }
                if (G == 256 && ctx_out && rep_ == 0) { __syncthreads();
                    ph_attention<false>(W_(bf16, WS_QB), W_(bf16, WS_KB), W_(bf16, WS_VB), W_(bf16, WS_Y), 512 + (bid - 40), 544, (char*)lds_raw, 216, nullptr, nullptr); }
                if (L + 1 < DEPTH) { const size_t wn = ((L + 1) & 1) ? (WS_WSET1 - WS_WIN) : 0;
                    __syncthreads();
                    ph_wconv(INP(8) + (size_t)(L + 1) * DM * 4624, INP(20) + (size_t)(L + 1) * DM * DM, INP(21) + (size_t)(L + 1) * DM * FF2, INP(24) + (size_t)(L + 1) * FF * DM, INP(17) + (size_t)(L + 1) * 2 * 2 * 8 * 4096,
                             W_(bf16, WS_WIN + wn), W_(bf16, WS_WOUT + wn), W_(bf16, WS_WUP + wn), W_(bf16, WS_WDN + wn), W_(bf16, WS_GWT + wn), lds, (bid - 40) * 8 + wave, (G - 40) * 8, wave, lane); } }
            }
            SEAM(pb + 4); }
        if (PHEN(6) && IN(pb + 5)) { REP(6) { WSL();
            if (bid >= G - 8 && rep_ == 0) ph_lru_carry(W_(float, WS_LCT), W_(float, WS_LCI), bid - (G - 8), tid);
            ph_attention<true>(W_(bf16, WS_QB), W_(bf16, WS_KB), W_(bf16, WS_VB), W_(bf16, WS_Y), bid, (ctx_out && G != 256) ? 544 : 512, (char*)lds_raw, G, INP(13) + L * 128, INP(14) + L * 128);
            }
            SEAM(pb + 5); }
        if (PHEN(8) && IN(pb + 6)) { REP(8) { WSL();
            ph_post(W_(bf16, WS_P), W_(bf16, WS_OF), W_(bf16, WS_OB), INP(12) + L * 128, W_(bf16, WS_LA), W_(bf16, WS_LU), W_(float, WS_LCI), W_(bf16, WS_Y), Mrows, gw, ngw, lane);
            }
            SEAM(pb + 6); }
        if (PHEN(9) && IN(pb + 7)) { REP(9) { WSL();
            pg8::Gemm g{W_(bf16, WS_Y), W_(bf16, WS_WOUT + wset), Mrows, DM, DM}; pg8::TailSplitOrder S; S.init(Mrows, DM, G, bid, DM); pg8::EpiResGate E{rep_ ? W_(bf16, WS_BIG + 160 * MiB + 2 * MiB) : W_(bf16, WS_X), DM, W_(float, WS_MOD) + (size_t)L * 5 * NMODV + 2 * DM, NMODV, W_(bf16, WS_SLAB)};
            pg8::gemm_phase<pg8::EpiResGate, pg8::TailSplitOrder, false, true>(lds, g, S, E);
            }
            SEAM(pb + 7); }
        if (PHEN(10) && IN(pb + 8)) { REP(10) { WSL();
            ph_norm_mod(W_(bf16, WS_X), INP(7) + L * DM, W_(float, WS_MOD) + (size_t)L * 5 * NMODV, 3 * DM, 4 * DM, W_(bf16, WS_H), Mrows, (ctx_out && G == 256) ? W_(bf16, WS_SLAB) : nullptr, gw, ngw, lane);
            }
            SEAM(pb + 8); }
        if (PHEN(11) && IN(pb + 9)) { REP(11) { WSL();
            pg8::Gemm g{W_(bf16, WS_H), W_(bf16, WS_WUP + wset), Mrows, FF2, DM}; pg8::StaticOrder S; S.init(Mrows, FF2, G, bid, DM);
            pg8::EpiConvGlu E{W_(bf16, WS_A), FF, INP(22) + (size_t)L * 3 * FF2, INP(23) + (size_t)L * FF2, W_(float, WS_U), lds + 131072};
            pg8::gemm_phase<pg8::EpiConvGlu, pg8::StaticOrder, true, true>(lds, g, S, E);
            }
            SEAM(pb + 9); }
        if (PHEN(12) && IN(pb + 10)) { REP(12) { WSL();
            ph_convfix(W_(float, WS_U), INP(22) + (size_t)L * 3 * FF2, INP(23) + (size_t)L * FF2, W_(bf16, WS_A), Mrows / 256, bid, G, tid);
            }
            SEAM(pb + 10); }
        if (PHEN(13) && IN(pb + 11)) { REP(13) { WSL();
            pg8::Gemm g{W_(bf16, WS_A), W_(bf16, WS_WDN + wset), Mrows, DM, FF}; pg8::TailSplitOrder S; S.init(Mrows, DM, G, bid, FF); pg8::EpiResGate E{rep_ ? W_(bf16, WS_BIG + 560 * MiB) : W_(bf16, WS_X), DM, W_(float, WS_MOD) + (size_t)L * 5 * NMODV + 5 * DM, NMODV, W_(bf16, WS_SLAB)};
            pg8::gemm_phase<pg8::EpiResGate, pg8::TailSplitOrder, false, true>(lds, g, S, E);
            }
            SEAM(pb + 11); }
    }
    if (PHEN(14) && IN(NPH - 1)) { WSL(); ph_final_norm(W_(bf16, WS_X), INP(25), (float*)((GAS float*)ka->out), gw, ngw, lane); }
#undef IN
#undef SEAM
#undef WSL
#undef INP
#undef W_
}

extern "C" void kernel_launch(void* const* d_in, const int* in_sizes, int n_in, void* d_out, int out_size, void* d_ws, size_t ws_size, hipStream_t stream) {
    static int grid = 0;
    if (grid == 0) {
        if (n_in != 26 || out_size != ML * DM || ws_size < WS_END) { fprintf(stderr, "kernel_launch: unexpected shapes (n_in %d out %d ws %zu, need ws >= %zu)\n", n_in, out_size, ws_size, (size_t)WS_END); grid = -1; return; }
        int dev = 0, cus = 0, per_cu = 0;
        if (hipGetDevice(&dev) != hipSuccess || hipDeviceGetAttribute(&cus, hipDeviceAttributeMultiprocessorCount, dev) != hipSuccess) { grid = -1; return; }
        if (hipFuncSetAttribute((const void*)fwd_kernel, hipFuncAttributeMaxDynamicSharedMemorySize, LDS_BYTES) != hipSuccess) { fprintf(stderr, "kernel_launch: hipFuncSetAttribute failed\n"); grid = -1; return; }
        if (hipOccupancyMaxActiveBlocksPerMultiprocessor(&per_cu, (const void*)fwd_kernel, 512, LDS_BYTES) != hipSuccess || per_cu < 1) { fprintf(stderr, "kernel_launch: occupancy query says %d blocks per CU\n", per_cu); }
        (void)hipGetLastError();
        grid = cus;
    }
    if (grid < 0) return;
    (void)hipMemsetAsync((char*)d_ws + WS_CTL, 0, CTL_ZERO_BYTES, stream);
    Args a{};
    for (int i = 0; i < 26; ++i) a.in[i] = (const float*)d_in[i];
    a.out = (float*)d_out; a.ws = (unsigned char*)d_ws;
#if MK_ONE_LAUNCH
    a.ph_lo = 0; a.ph_hi = NPH;
    hipLaunchKernelGGL(fwd_kernel, dim3(grid), dim3(512), LDS_BYTES, stream, a);
#else
    for (int p = 0; p < NPH; ++p) { a.ph_lo = p; a.ph_hi = p + 1; hipLaunchKernelGGL(fwd_kernel, dim3(grid), dim3(512), LDS_BYTES, stream, a); }
#endif
    const hipError_t le = hipPeekAtLastError();
    if (le != hipSuccess) fprintf(stderr, "kernel_launch: launch failed: %s\n", hipGetErrorName(le));
}
```

```cpp
#include <hip/hip_runtime.h>
#include <hip/hip_bf16.h>
#include <cstdio>
#include <cstdint>
#ifndef MK_ONE_LAUNCH
#define MK_ONE_LAUNCH 1
#endif
#ifndef DUP_PH
#define DUP_PH -1
#endif
#ifndef DUP_SUB
#define DUP_SUB 0
#endif
#ifndef DUP_BAR
#define DUP_BAR 0
#endif
namespace pg8 {
#define PG8_LAS __attribute__((address_space(3)))
typedef unsigned short bf16_t;
typedef short bf16x8 __attribute__((ext_vector_type(8)));
typedef float f32x4 __attribute__((ext_vector_type(4)));
typedef unsigned u32x4 __attribute__((ext_vector_type(4)));
constexpr int BM = 256, BK = 64, HALF = 128, HTB = HALF * BK * 2  , STAGE_BYTES = 8 * HTB, NXCD = 8, WGM = 8;

__host__ __device__ __forceinline__ int lds_byte(int r, int c) { const int st = (r >> 4) * 2 + (c >> 5), rr = r & 15, cc = c & 31, ob = rr * 64 + cc * 2; return st * 1024 + (ob ^ (((ob >> 9) & 1) << 5)); }
__host__ __device__ __forceinline__ void stage_rc(int b, int& R, int& C) { const int st = b / 1024, sb = b % 1024, swz = sb ^ (((sb >> 9) & 1) << 5); R = (st >> 1) * 16 + swz / 64; C = (st & 1) * 32 + (swz % 64) / 2; }
__host__ __device__ __forceinline__ int perm32(int rho) { const int n = rho >> 4, i = rho & 15; return 8 * (i >> 2) + 4 * n + (i & 3); }

struct Unit { int pm, pn, koff, nt, split; };
struct Gemm { const bf16_t* A; const bf16_t* Bt; int M, N, K; };

struct StaticOrder {
    int nM, nN, nwg, G, c, ntk;
    __host__ __device__ void init(int M, int N, int G_, int c_, int K_) { nM = M / BM; nN = N / BM; nwg = nM * nN; G = G_; c = c_; ntk = K_ / BK; }
    __host__ __device__ bool next(int i, Unit& u) const {
        const long L = (long)i * G + c; if (L >= nwg) return false;
        int wgid = (int)L; { const int q = nwg / NXCD, r = nwg % NXCD, xcd = wgid % NXCD, off = wgid / NXCD; wgid = (xcd < r ? xcd * (q + 1) : r * (q + 1) + (xcd - r) * q) + off; }
        const int nig = WGM * nN, gid = wgid / nig, fm = gid * WGM, gsz = (nM - fm) < WGM ? (nM - fm) : WGM;
        u.pm = fm + ((wgid % nig) % gsz); u.pn = (wgid % nig) / gsz; u.koff = 0; u.nt = ntk; u.split = 0; return true;
    }
    __device__ __forceinline__ void a_ready(const Unit&) const {}
    __device__ __forceinline__ void done(const Unit&) const {}
};
struct TailSplitOrder {
    StaticOrder full, all; int G, c, nbk, tail;
    __host__ __device__ void init(int M, int N, int G_, int c_, int K_) { G = G_; c = c_; nbk = K_ / 128; tail = (G_ == 256 && M == 68 * BM && N == 8 * BM) ? 1 : 0; full.init(64 * BM, N, G_, c_, K_); all.init(M, N, G_, c_, K_); }
    __host__ __device__ bool next(int i, Unit& u) const {
        if (!tail) return all.next(i, u);
        if (i < 2) {
            const int x = c & 7, j = c >> 3; u.pm = 8 * x + 4 * i + (j & 3); u.pn = j >> 2; u.koff = 0; u.nt = full.ntk; u.split = 0; return true; }
        if (i > 2) return false;
        const int t = c >> 3, p = c & 7, base = nbk >> 3, rem = nbk & 7, start = p * base + (p < rem ? p : rem), len = base + (p < rem ? 1 : 0);
        u.pm = 64 + (t >> 3); u.pn = t & 7; u.koff = start * 128; u.nt = 2 * len; u.split = p + 1; return true;
    }
    __device__ __forceinline__ void a_ready(const Unit&) const {}
    __device__ __forceinline__ void done(const Unit&) const {}
};


__device__ __forceinline__ unsigned cvt_pk_bf16(float lo, float hi) { unsigned r; asm volatile("v_cvt_pk_bf16_f32 %0, %1, %2" : "=v"(r) : "v"(lo), "v"(hi)); return r; }
typedef float f32x2 __attribute__((ext_vector_type(2)));

struct EpiStoreF32 {
    static constexpr bool PERM = false, AFTER_DRAIN = false;
    float* C; int ldc;
    __device__ __forceinline__ void operator()(const f32x4 (&acc)[2][2][4][2], const Unit& u, int wr, int wc, int fr, int fq) const {
        const int row0 = u.pm * BM + wr * 64 + fr, col0 = u.pn * BM + wc * 32 + 4 * fq;
#pragma unroll
        for (int ai = 0; ai < 2; ++ai)
#pragma unroll
            for (int m = 0; m < 4; ++m) { float* rowp = C + (size_t)(row0 + ai * HALF + m * 16) * ldc + col0;
#pragma unroll
                for (int bj = 0; bj < 2; ++bj)
#pragma unroll
                    for (int n = 0; n < 2; ++n) *(f32x4*)(rowp + bj * HALF + n * 16) = acc[ai][bj][m][n]; }
    }
};
struct EpiResGate {
    static constexpr bool PERM = true, AFTER_DRAIN = false;
    bf16_t* X; int ldc; const float* gate; int gstride; bf16_t* slab;
    __device__ __forceinline__ void operator()(const f32x4 (&acc)[2][2][4][2], const Unit& u, int wr, int wc, int fr, int fq) const {
        const int row0 = u.pm * BM + wr * 64 + fr, col0 = u.pn * BM + wc * 32 + 8 * fq;
        const int bidx = u.pm < 64 ? (u.pm >> 4) : 4;
        const float* gp = gate + (size_t)bidx * gstride + col0;
        f32x4 gv[2][2];
#pragma unroll
        for (int bj = 0; bj < 2; ++bj)
#pragma unroll
            for (int n = 0; n < 2; ++n) gv[bj][n] = *(const f32x4*)(gp + bj * HALF + 4 * n);
        if (u.split) {
            bf16_t* base = slab + ((size_t)(u.split - 1) * 1024 - 16384) * ldc;
#pragma unroll
            for (int ai = 0; ai < 2; ++ai)
#pragma unroll
                for (int m = 0; m < 4; ++m) { bf16_t* rowp = base + (size_t)(row0 + ai * HALF + m * 16) * ldc + col0;
#pragma unroll
                    for (int bj = 0; bj < 2; ++bj) { const f32x4 v0 = gv[bj][0] * acc[ai][bj][m][0], v1 = gv[bj][1] * acc[ai][bj][m][1];
                        u32x4 w; w.x = cvt_pk_bf16(v0[0], v0[1]); w.y = cvt_pk_bf16(v0[2], v0[3]); w.z = cvt_pk_bf16(v1[0], v1[1]); w.w = cvt_pk_bf16(v1[2], v1[3]);
                        *(u32x4*)(rowp + bj * HALF) = w; } }
        } else {
#pragma unroll
            for (int ai = 0; ai < 2; ++ai) { u32x4 x[4][2];
#pragma unroll
                for (int m = 0; m < 4; ++m) { const bf16_t* rowp = X + (size_t)(row0 + ai * HALF + m * 16) * ldc + col0;
#pragma unroll
                    for (int bj = 0; bj < 2; ++bj) x[m][bj] = *(const u32x4*)(rowp + bj * HALF); }
#pragma unroll
                for (int m = 0; m < 4; ++m) { bf16_t* rowp = X + (size_t)(row0 + ai * HALF + m * 16) * ldc + col0;
#pragma unroll
                    for (int bj = 0; bj < 2; ++bj) { const u32x4 xw = x[m][bj];
                        const f32x4 x0 = {__builtin_bit_cast(float, xw.x << 16), __builtin_bit_cast(float, xw.x & 0xffff0000u), __builtin_bit_cast(float, xw.y << 16), __builtin_bit_cast(float, xw.y & 0xffff0000u)};
                        const f32x4 x1 = {__builtin_bit_cast(float, xw.z << 16), __builtin_bit_cast(float, xw.z & 0xffff0000u), __builtin_bit_cast(float, xw.w << 16), __builtin_bit_cast(float, xw.w & 0xffff0000u)};
                        const f32x4 v0 = x0 + gv[bj][0] * acc[ai][bj][m][0], v1 = x1 + gv[bj][1] * acc[ai][bj][m][1];
                        u32x4 w; w.x = cvt_pk_bf16(v0[0], v0[1]); w.y = cvt_pk_bf16(v0[2], v0[3]); w.z = cvt_pk_bf16(v1[0], v1[1]); w.w = cvt_pk_bf16(v1[2], v1[3]);
                        *(u32x4*)(rowp + bj * HALF) = w; } }
                asm volatile("" ::: "memory"); }
        }
    }
};
struct EpiStoreBf16 {
    static constexpr bool PERM = true, AFTER_DRAIN = false;
    bf16_t* O; int ldc;
    __device__ __forceinline__ void operator()(const f32x4 (&acc)[2][2][4][2], const Unit& u, int wr, int wc, int fr, int fq) const {
        const int row0 = u.pm * BM + wr * 64 + fr, col0 = u.pn * BM + wc * 32 + 8 * fq;
#pragma unroll
        for (int ai = 0; ai < 2; ++ai)
#pragma unroll
            for (int m = 0; m < 4; ++m) { bf16_t* rowp = O + (size_t)(row0 + ai * HALF + m * 16) * ldc + col0;
#pragma unroll
                for (int bj = 0; bj < 2; ++bj) { const f32x4 v0 = acc[ai][bj][m][0], v1 = acc[ai][bj][m][1];
                    u32x4 w; w.x = cvt_pk_bf16(v0[0], v0[1]); w.y = cvt_pk_bf16(v0[2], v0[3]); w.z = cvt_pk_bf16(v1[0], v1[1]); w.w = cvt_pk_bf16(v1[2], v1[3]);
                    *(u32x4*)(rowp + bj * HALF) = w; } }
    }
};


struct EpiConvGlu {
    static constexpr bool PERM = true, AFTER_DRAIN = false;
    bf16_t* A; int FFd; const float* cw; const float* cb; float* RAW; PG8_LAS unsigned char* xlds;
    static __device__ __forceinline__ float dpp_ror1(float v) { return __builtin_bit_cast(float, __builtin_amdgcn_mov_dpp(__builtin_bit_cast(int, v), 0x121, 0xf, 0xf, false)); }
    static __device__ __forceinline__ float dpp_ror15(float v) { return __builtin_bit_cast(float, __builtin_amdgcn_mov_dpp(__builtin_bit_cast(int, v), 0x12f, 0xf, 0xf, false)); }
    static __device__ __forceinline__ float silu(float x) { return x * __builtin_amdgcn_rcpf(1.0f + __builtin_amdgcn_exp2f(-1.4426950408889634f * x)); }
    __device__ __forceinline__ void operator()(const f32x4 (&acc)[2][2][4][2], const Unit& u, int wr, int wc, int fr, int fq) const {
        const int cidx = wc * 32 + 8 * fq, col = u.pn * 128 + cidx;
        PG8_LAS float* X = (PG8_LAS float*)xlds;
        if (fr == 0 || fr == 15) {
#pragma unroll
            for (int ai = 0; ai < 2; ++ai) { const int m = fr == 0 ? 0 : 3; PG8_LAS float* dst = X + ((wc * 4 + 2 * ai + wr) * 2 + (fr == 0 ? 0 : 1)) * 64 + 8 * fq;
#pragma unroll
                for (int bj = 0; bj < 2; ++bj) { *(PG8_LAS f32x4*)(dst + bj * 32) = fr == 0 ? acc[ai][bj][0][0] : acc[ai][bj][3][0]; *(PG8_LAS f32x4*)(dst + bj * 32 + 4) = fr == 0 ? acc[ai][bj][0][1] : acc[ai][bj][3][1]; } (void)m; } }
        { const bool top = (wr == 0 && fr < 2), bot = (wr == 1 && fr >= 14);
          if (top || bot) { const int slot = top ? fr : fr - 12; float* dst = RAW + ((size_t)u.pm * 4 + slot) * (2 * FFd) + col;
#pragma unroll
              for (int bj = 0; bj < 2; ++bj) { *(f32x4*)(dst + bj * FFd) = top ? acc[0][bj][0][0] : acc[1][bj][3][0]; *(f32x4*)(dst + bj * FFd + 4) = top ? acc[0][bj][0][1] : acc[1][bj][3][1]; } } }
        asm volatile("s_waitcnt lgkmcnt(0)" ::: "memory"); __builtin_amdgcn_s_barrier(); asm volatile("" ::: "memory");
#pragma unroll
        for (int n = 0; n < 2; ++n) {
            f32x4 wt[2][4];
#pragma unroll
            for (int bj = 0; bj < 2; ++bj) { const float* wp = cw + bj * FFd + col + 4 * n; wt[bj][0] = *(const f32x4*)wp; wt[bj][1] = *(const f32x4*)(wp + 2 * FFd); wt[bj][2] = *(const f32x4*)(wp + 4 * FFd); wt[bj][3] = *(const f32x4*)(cb + bj * FFd + col + 4 * n); }
#pragma unroll
            for (int ai = 0; ai < 2; ++ai) { const int bi = 2 * ai + wr;
                asm volatile("" ::: "memory");
                f32x4 res[4];
#pragma unroll
                for (int bj = 0; bj < 2; ++bj) {
                    const f32x4 w0 = wt[bj][0], w1 = wt[bj][1], w2 = wt[bj][2], bb = wt[bj][3];
                    f32x4 pm1 = {0.f, 0.f, 0.f, 0.f}, ne = {0.f, 0.f, 0.f, 0.f};
                    if (bi > 0) pm1 = *(const PG8_LAS f32x4*)(X + ((wc * 4 + bi - 1) * 2 + 1) * 64 + 8 * fq + bj * 32 + 4 * n);
                    if (bi < 3) ne = *(const PG8_LAS f32x4*)(X + ((wc * 4 + bi + 1) * 2 + 0) * 64 + 8 * fq + bj * 32 + 4 * n);
                    f32x4 ncur;
#pragma unroll
                    for (int q = 0; q < 4; ++q) ncur[q] = dpp_ror15(acc[ai][bj][0][n][q]);
#pragma unroll
                    for (int m = 0; m < 4; ++m) { f32x4 pm, nnext = ne;
#pragma unroll
                        for (int q = 0; q < 4; ++q) { pm[q] = dpp_ror1(acc[ai][bj][m][n][q]); if (m < 3) nnext[q] = dpp_ror15(acc[ai][bj][m < 3 ? m + 1 : 3][n][q]); }
                        const f32x4 prev = fr > 0 ? pm : pm1, next = fr < 15 ? ncur : nnext;
                        const f32x4 c = bb + w0 * prev + w1 * acc[ai][bj][m][n] + w2 * next;
                        if (bj == 0) { res[m][0] = silu(c[0]); res[m][1] = silu(c[1]); res[m][2] = silu(c[2]); res[m][3] = silu(c[3]); } else res[m] = res[m] * c;
                        pm1 = pm; ncur = nnext; __builtin_amdgcn_sched_barrier(0); }
                    }
#pragma unroll
                for (int m = 0; m < 4; ++m) { typedef unsigned u32x2 __attribute__((ext_vector_type(2))); u32x2 o; o.x = cvt_pk_bf16(res[m][0], res[m][1]); o.y = cvt_pk_bf16(res[m][2], res[m][3]);
                    *(u32x2*)(A + (size_t)(u.pm * BM + ai * HALF + wr * 64 + m * 16 + fr) * FFd + col + 4 * n) = o; } } }
    }
};
template <class Epi, class Sched, bool ALIGN_EPI = false, bool SP2 = false>
__device__ __forceinline__ void gemm_phase(PG8_LAS unsigned char* lds, const Gemm g, const Sched& S, const Epi& E) {
    int tid_o = threadIdx.x; asm volatile("" : "+v"(tid_o));
    int tid = tid_o; const int wid = __builtin_amdgcn_readfirstlane(tid >> 6), wr = wid >> 2, wc = wid & 3; int lane = tid & 63, fr = lane & 15, fq = lane >> 4;
    const int K = g.K;
    unsigned voffA[2], voffB[2];
#pragma unroll
    for (int i = 0; i < 2; ++i) { int R, C; stage_rc(tid * 16 + i * 8192, R, C); const int Rb = Epi::PERM ? ((R & ~31) + perm32(R & 31)) : R;
        voffA[i] = (unsigned)(R * K + C) * 2u; voffB[i] = (unsigned)(Rb * K + C) * 2u; }
    const size_t kstep = (size_t)(BK * 2);
    const size_t hstep = (size_t)HALF * K * 2;
    const size_t tstep = 2 * hstep;
    const unsigned ldsw = (unsigned)wid * 1024u;
    int aoff = lds_byte(wr * 64 + fr, fq * 8), boff = lds_byte(wc * 32 + fr, fq * 8);
#define PG8_RELANE() do { tid = threadIdx.x; asm volatile("" : "+v"(tid)); lane = tid & 63; fr = lane & 15; fq = lane >> 4; \
        _Pragma("unroll") for (int i = 0; i < 2; ++i) { int R, C; stage_rc(tid * 16 + i * 8192, R, C); const int Rb = Epi::PERM ? ((R & ~31) + perm32(R & 31)) : R; \
            voffA[i] = (unsigned)(R * K + C) * 2u; voffB[i] = (unsigned)(Rb * K + C) * 2u; } \
        aoff = lds_byte(wr * 64 + fr, fq * 8); boff = lds_byte(wc * 32 + fr, fq * 8); } while (0)
#define PG8_SA(b, h) (((b) * 2 + (h)) * HTB)
#define PG8_SB(b, h) ((4 + (b) * 2 + (h)) * HTB)
#define PG8_STAGE(bufoff, gbase, voff) do { _Pragma("unroll") for (int _i = 0; _i < 2; ++_i) \
        __builtin_amdgcn_global_load_lds((const unsigned*)((const char*)(gbase) + (voff)[_i]), (PG8_LAS unsigned*)(lds + (bufoff) + ldsw + _i * 8192), 16, 0, 0); } while (0)
#define PG8_LDA(dst, b, h) do { _Pragma("unroll") for (int m = 0; m < 4; ++m) _Pragma("unroll") for (int k = 0; k < 2; ++k) dst[m][k] = *(const PG8_LAS bf16x8*)(lds + PG8_SA(b, h) + aoff + m * 2048 + k * 1024); } while (0)
#define PG8_LDB(dst, b, h) do { _Pragma("unroll") for (int n = 0; n < 2; ++n) _Pragma("unroll") for (int k = 0; k < 2; ++k) dst[n][k] = *(const PG8_LAS bf16x8*)(lds + PG8_SB(b, h) + boff + n * 2048 + k * 1024); } while (0)
#define PG8_MMA(ai, bj, At, Bt) do { __builtin_amdgcn_s_setprio(1); _Pragma("unroll") for (int m = 0; m < 4; ++m) _Pragma("unroll") for (int n = 0; n < 2; ++n) _Pragma("unroll") for (int k = 0; k < 2; ++k) \
        acc[ai][bj][m][n] = __builtin_amdgcn_mfma_f32_16x16x32_bf16(Bt[n][k], At[m][k], acc[ai][bj][m][n], 0, 0, 0); __builtin_amdgcn_s_setprio(0); } while (0)
#define PG8_WAIT_V(n) asm volatile("s_waitcnt vmcnt(" #n ")" ::: "memory")
#define PG8_WAIT_L(n) asm volatile("s_waitcnt lgkmcnt(" #n ")" ::: "memory")
#define PG8_BAR __builtin_amdgcn_s_barrier()
#define PG8_SCHED __builtin_amdgcn_sched_barrier(0)
    Unit cur, nxt; int ui = 0;
    if (!S.next(0, cur)) return;
    f32x4 acc[2][2][4][2];
#pragma unroll
    for (int a = 0; a < 2; ++a)
#pragma unroll
        for (int b = 0; b < 2; ++b)
#pragma unroll
            for (int m = 0; m < 4; ++m)
#pragma unroll
                for (int n = 0; n < 2; ++n) acc[a][b][m][n] = (f32x4){0.f, 0.f, 0.f, 0.f};
    bf16x8 At[4][2], B0[2][2], B1[2][2];
    const char* cA = (const char*)g.A + (size_t)cur.pm * tstep + (size_t)cur.koff * 2; const char* cB = (const char*)g.Bt + (size_t)cur.pn * tstep + (size_t)cur.koff * 2;
    S.a_ready(cur);
    if constexpr (SP2) {
        PG8_STAGE(PG8_SB(0, 0), cB, voffB); PG8_STAGE(PG8_SB(0, 1), cB + hstep, voffB); PG8_STAGE(PG8_SA(0, 0), cA, voffA); PG8_STAGE(PG8_SA(0, 1), cA + hstep, voffA);
        if (wr == 1) PG8_BAR;
        PG8_WAIT_V(2); PG8_BAR;
        PG8_STAGE(PG8_SB(1, 0), cB + kstep, voffB); PG8_STAGE(PG8_SA(1, 0), cA + kstep, voffA); PG8_STAGE(PG8_SB(1, 1), cB + hstep + kstep, voffB);
        PG8_WAIT_V(6); PG8_BAR;
    } else {
        PG8_STAGE(PG8_SB(0, 0), cB, voffB); PG8_STAGE(PG8_SA(0, 0), cA, voffA); PG8_STAGE(PG8_SB(0, 1), cB + hstep, voffB); PG8_STAGE(PG8_SA(0, 1), cA + hstep, voffA);
        if (wr == 1) PG8_BAR;
        PG8_WAIT_V(4); PG8_BAR;
        PG8_STAGE(PG8_SB(1, 0), cB + kstep, voffB); PG8_STAGE(PG8_SA(1, 0), cA + kstep, voffA); PG8_STAGE(PG8_SB(1, 1), cB + hstep + kstep, voffB);
        PG8_WAIT_V(6); PG8_BAR;
    }
    for (;;) {
        const bool has_next = S.next(ui + 1, nxt);
        const char* nA = has_next ? (const char*)g.A + (size_t)nxt.pm * tstep + (size_t)nxt.koff * 2 : cA; const char* nB = has_next ? (const char*)g.Bt + (size_t)nxt.pn * tstep + (size_t)nxt.koff * 2 : cB;
        const int nt = cur.nt;
        for (int t = 0; t < nt; t += 2) {
            const bool last = (t == nt - 2);
            const char* a1 = cA + (size_t)(t + 1) * kstep;
            const char* a2 = last ? nA : cA + (size_t)(t + 2) * kstep; const char* b2 = last ? nB : cB + (size_t)(t + 2) * kstep;
            const char* a3 = a2 + kstep; const char* b3 = b2 + kstep;
            if (last && has_next) S.a_ready(nxt);
            if constexpr (SP2) {
            PG8_LDB(B0, 0, 0); PG8_LDB(B1, 0, 1); PG8_SCHED; PG8_LDA(At, 0, 0); PG8_STAGE(PG8_SA(1, 1), a1 + hstep, voffA);
            PG8_WAIT_V(8); PG8_WAIT_L(0); PG8_BAR; PG8_MMA(0, 0, At, B0); PG8_MMA(0, 1, At, B1); PG8_BAR; PG8_SCHED;
            PG8_LDA(At, 0, 1); PG8_STAGE(PG8_SB(0, 0), b2, voffB); PG8_STAGE(PG8_SB(0, 1), b2 + hstep, voffB); PG8_STAGE(PG8_SA(0, 0), a2, voffA);
            PG8_WAIT_V(8); PG8_WAIT_L(0); PG8_BAR; PG8_MMA(1, 0, At, B0); PG8_MMA(1, 1, At, B1); PG8_BAR; PG8_SCHED;
            PG8_LDB(B0, 1, 0); PG8_LDB(B1, 1, 1); PG8_SCHED; PG8_LDA(At, 1, 0); PG8_STAGE(PG8_SA(0, 1), a2 + hstep, voffA);
            PG8_WAIT_V(8); PG8_WAIT_L(0); PG8_BAR; PG8_MMA(0, 0, At, B0); PG8_MMA(0, 1, At, B1); PG8_BAR; PG8_SCHED;
            PG8_LDA(At, 1, 1); PG8_STAGE(PG8_SB(1, 0), b3, voffB); PG8_STAGE(PG8_SB(1, 1), b3 + hstep, voffB); PG8_STAGE(PG8_SA(1, 0), a3, voffA);
            PG8_WAIT_V(8); PG8_WAIT_L(0); PG8_BAR; PG8_MMA(1, 0, At, B0); PG8_MMA(1, 1, At, B1); PG8_BAR; PG8_SCHED;
            } else {
            PG8_LDB(B0, 0, 0); PG8_SCHED; PG8_LDA(At, 0, 0); PG8_STAGE(PG8_SA(1, 1), a1 + hstep, voffA);
            PG8_WAIT_L(8); PG8_BAR; PG8_WAIT_L(0); PG8_MMA(0, 0, At, B0); PG8_BAR; PG8_SCHED;
            PG8_LDB(B1, 0, 1); PG8_STAGE(PG8_SB(0, 0), b2, voffB);
            PG8_BAR; PG8_WAIT_L(0); PG8_MMA(0, 1, At, B1); PG8_BAR;
            PG8_LDA(At, 0, 1); PG8_STAGE(PG8_SA(0, 0), a2, voffA);
            PG8_BAR; PG8_WAIT_L(0); PG8_MMA(1, 0, At, B0); PG8_BAR; PG8_SCHED;
            PG8_STAGE(PG8_SB(0, 1), b2 + hstep, voffB);
            PG8_WAIT_V(6); PG8_BAR; PG8_MMA(1, 1, At, B1); PG8_BAR;
            PG8_LDB(B0, 1, 0); PG8_SCHED; PG8_LDA(At, 1, 0); PG8_STAGE(PG8_SA(0, 1), a2 + hstep, voffA);
            PG8_WAIT_L(8); PG8_BAR; PG8_WAIT_L(0); PG8_MMA(0, 0, At, B0); PG8_BAR; PG8_SCHED;
            PG8_LDB(B1, 1, 1); PG8_STAGE(PG8_SB(1, 0), b3, voffB);
            PG8_BAR; PG8_WAIT_L(0); PG8_MMA(0, 1, At, B1); PG8_BAR;
            PG8_LDA(At, 1, 1); PG8_STAGE(PG8_SA(1, 0), a3, voffA);
            PG8_BAR; PG8_WAIT_L(0); PG8_MMA(1, 0, At, B0); PG8_BAR; PG8_SCHED;
            PG8_STAGE(PG8_SB(1, 1), b3 + hstep, voffB);
            PG8_WAIT_V(6); PG8_BAR; PG8_MMA(1, 1, At, B1); PG8_BAR;
            }
        }
        if constexpr (ALIGN_EPI) { if (wr == 0) PG8_BAR; }
        if constexpr (!Epi::AFTER_DRAIN) { E(acc, cur, wr, wc, fr, fq); S.done(cur); PG8_RELANE(); }
        if (!has_next) break;
#pragma unroll
        for (int a = 0; a < 2; ++a)
#pragma unroll
            for (int b = 0; b < 2; ++b)
#pragma unroll
                for (int m = 0; m < 4; ++m)
#pragma unroll
                    for (int n = 0; n < 2; ++n) acc[a][b][m][n] = (f32x4){0.f, 0.f, 0.f, 0.f};
        cur = nxt; cA = nA; cB = nB; ++ui;
        if constexpr (ALIGN_EPI) { if (wr == 1) PG8_BAR; }
    }
    PG8_WAIT_V(0);
    if constexpr (!ALIGN_EPI) { if (wr == 0) PG8_BAR; }
    PG8_BAR;
    if constexpr (Epi::AFTER_DRAIN) { E.fused(acc, cur, wr, wc, fr, fq, lds, wid, lane); S.done(cur); }
#undef PG8_SA
#undef PG8_SB
#undef PG8_STAGE
#undef PG8_LDA
#undef PG8_LDB
#undef PG8_MMA
#undef PG8_WAIT_V
#undef PG8_WAIT_L
#undef PG8_BAR
#undef PG8_SCHED
#undef PG8_RELANE
}
}
namespace att {
using bf16 = __hip_bfloat16;
constexpr int   D = 128, NW = 8, QBLK = 32, KVBLK = 64;
constexpr float SCALE = 0.088388347648318440f;
constexpr float THR = 8.f;
constexpr int SDEPTH = 2;
constexpr int LDQ = 1024, LDK = 256, LDO = 2048;
constexpr size_t SHM_V = KVBLK * D * 2, SHM_K = KVBLK * D * 2, SHM_ATTN = 2 * SHM_V + 2 * SHM_K + NW * 64 * 4;
__device__ __forceinline__ unsigned short f2bf_rne(float f) { unsigned u = __builtin_bit_cast(unsigned, f); return (unsigned short)((u + 0x7fffu + ((u >> 16) & 1u)) >> 16); }
using bf16x8 = __attribute__((ext_vector_type(8))) short;
using s16x4  = __attribute__((ext_vector_type(4))) short;
using f32x16 = __attribute__((ext_vector_type(16))) float;
using f32x8  = __attribute__((ext_vector_type(8))) float;
using u32x4  = __attribute__((ext_vector_type(4))) unsigned;
#define KSWZ(row, colB) ((row) * 256 + ((colB) ^ (((row) & 7) << 4)))
#define SBAR() __builtin_amdgcn_sched_barrier(0)
__device__ __forceinline__ int crow(int r, int hi) { return (r & 3) + 8 * (r >> 2) + 4 * hi; }
__device__ __forceinline__ unsigned cvtpk(float lo, float hi) {
  unsigned r; asm volatile("v_cvt_pk_bf16_f32 %0, %1, %2" : "=v"(r) : "v"(lo), "v"(hi)); return r;
}
template <typename TIn> struct Stage;
template <> struct Stage<bf16>  { using T = bf16x8;
  __device__ static __forceinline__ T ld8(const bf16* p) { return *reinterpret_cast<const bf16x8*>(p); }
  __device__ static __forceinline__ bf16x8 tobf(T x) { return x; } };
template <> struct Stage<float> { using T = f32x8;
  __device__ static __forceinline__ T ld8(const float* p) { return *reinterpret_cast<const f32x8*>(p); }
  __device__ static __forceinline__ bf16x8 tobf(T x) {
    u32x4 w = {cvtpk(x[0], x[1]), cvtpk(x[2], x[3]), cvtpk(x[4], x[5]), cvtpk(x[6], x[7])}; return *reinterpret_cast<bf16x8*>(&w); } };

__device__ __forceinline__ void partialSM(f32x16& p0, f32x16& p1, float& m_reg, float& mn, float& alpha) {
  constexpr float THR2 = THR * 1.4426950408889634f;
  float pmax = p0[0]; for (int r = 1; r < 16; ++r) pmax = fmaxf(pmax, p0[r]); for (int r = 0; r < 16; ++r) pmax = fmaxf(pmax, p1[r]);
  { auto rr = __builtin_amdgcn_permlane32_swap(__float_as_uint(pmax), __float_as_uint(pmax), false, false);
    pmax = fmaxf(__uint_as_float(rr[0]), __uint_as_float(rr[1])); }
  if (__builtin_expect(__all(pmax - m_reg <= THR2), 1)) { mn = m_reg; alpha = 1.f; }
  else { mn = fmaxf(m_reg, pmax); alpha = __builtin_amdgcn_exp2f(m_reg - mn); m_reg = mn; }
  for (int r = 0; r < 16; ++r) p0[r] = p0[r] - mn; for (int r = 0; r < 16; ++r) p1[r] = p1[r] - mn;
  for (int r = 0; r < 16; ++r) p0[r] = __builtin_amdgcn_exp2f(p0[r]);
}
__device__ __forceinline__ void partialSM_fixed(f32x16& p0, f32x16& p1) {
  for (int r = 0; r < 16; ++r) p0[r] = __builtin_amdgcn_exp2f(p0[r]);
  (void)p1;
}
__device__ __forceinline__ void finishSM(f32x16& p0, f32x16& p1, float alpha, float& l_reg, bf16x8& pa0, bf16x8& pa1, bf16x8& pa2, bf16x8& pa3) {
  for (int r = 0; r < 16; ++r) p1[r] = __builtin_amdgcn_exp2f(p1[r]);
  float ps = 0; for (int r = 0; r < 16; ++r) ps += p0[r]; for (int r = 0; r < 16; ++r) ps += p1[r];
  { auto rr = __builtin_amdgcn_permlane32_swap(__float_as_uint(ps), __float_as_uint(ps), false, false);
    ps = __uint_as_float(rr[0]) + __uint_as_float(rr[1]); }
  l_reg = l_reg * alpha + ps;
#define PK4(P, BASE, OUT) do { unsigned a0 = cvtpk(P[BASE + 0], P[BASE + 1]), a1 = cvtpk(P[BASE + 2], P[BASE + 3]);   \
    unsigned b0 = cvtpk(P[BASE + 4], P[BASE + 5]), b1 = cvtpk(P[BASE + 6], P[BASE + 7]);                              \
    auto r0 = __builtin_amdgcn_permlane32_swap(a0, b0, false, false); auto r1 = __builtin_amdgcn_permlane32_swap(a1, b1, false, false); \
    u32x4 w = {r0[0], r1[0], r0[1], r1[1]}; OUT = *reinterpret_cast<bf16x8*>(&w); } while (0)
  PK4(p0, 0, pa0); PK4(p0, 8, pa1); PK4(p1, 0, pa2); PK4(p1, 8, pa3);
#undef PK4
}
__device__ __forceinline__ void qkt(f32x16& p0, f32x16& p1, const bf16* Ks, const bf16x8* qr, int r32, int hi) {
  p0 = f32x16{}; p1 = f32x16{};
  for (int d0 = 0; d0 < 8; ++d0) { int cb = (d0 * 16 + hi * 8) * 2;
    bf16x8 b0 = *reinterpret_cast<const bf16x8*>((const char*)Ks + KSWZ(r32, cb));
    bf16x8 b1 = *reinterpret_cast<const bf16x8*>((const char*)Ks + KSWZ(32 + r32, cb));
    p0 = __builtin_amdgcn_mfma_f32_32x32x16_bf16(b0, qr[d0], p0, 0, 0, 0);
    p1 = __builtin_amdgcn_mfma_f32_32x32x16_bf16(b1, qr[d0], p1, 0, 0, 0); }
}
__device__ __forceinline__ int v_st(int k, int c) { const int kk = (k & ~0xC) | ((k & 4) << 1) | ((k & 8) >> 1); return ((kk >> 3) * 4 + (c >> 5)) * 512 + ((kk & 7) * 32 + (c & 31)) * 2; }
__device__ __forceinline__ int v_rd_base(int lane) { return ((lane & 3) << 3) | (((lane >> 2) & 3) << 6) | (((lane >> 4) & 1) << 5) | (((lane >> 5) & 1) << 8); }
constexpr int v_rd_off(int d0, int ks, int half) { return d0 * 512 + ks * 4096 + half * 2048; }
template <int OFF> __device__ __forceinline__ s16x4 tr_read(int vb) {
  s16x4 r; asm volatile("ds_read_b64_tr_b16 %0, %1 offset:%2" : "=&v"(r) : "v"(vb), "i"(OFF) : "memory"); return r;
}
template <int D0> __device__ __forceinline__ void pv_one(f32x16& od, int vb, bf16x8 pa0, bf16x8 pa1, bf16x8 pa2, bf16x8 pa3) {
  const s16x4 l0 = tr_read<v_rd_off(D0, 0, 0)>(vb), h0 = tr_read<v_rd_off(D0, 0, 1)>(vb), l1 = tr_read<v_rd_off(D0, 1, 0)>(vb), h1 = tr_read<v_rd_off(D0, 1, 1)>(vb);
  const s16x4 l2 = tr_read<v_rd_off(D0, 2, 0)>(vb), h2 = tr_read<v_rd_off(D0, 2, 1)>(vb), l3 = tr_read<v_rd_off(D0, 3, 0)>(vb), h3 = tr_read<v_rd_off(D0, 3, 1)>(vb);
  asm volatile("s_waitcnt lgkmcnt(0)" ::: "memory"); SBAR();
#define PK(L, H) (bf16x8){L[0], L[1], L[2], L[3], H[0], H[1], H[2], H[3]}
  od = __builtin_amdgcn_mfma_f32_32x32x16_bf16(pa0, PK(l0, h0), od, 0, 0, 0);
  od = __builtin_amdgcn_mfma_f32_32x32x16_bf16(pa1, PK(l1, h1), od, 0, 0, 0);
  od = __builtin_amdgcn_mfma_f32_32x32x16_bf16(pa2, PK(l2, h2), od, 0, 0, 0);
  od = __builtin_amdgcn_mfma_f32_32x32x16_bf16(pa3, PK(l3, h3), od, 0, 0, 0);
#undef PK
}
__device__ __forceinline__ void pv_d0(f32x16* o, int vb, bf16x8 pa0, bf16x8 pa1, bf16x8 pa2, bf16x8 pa3) {
  pv_one<0>(o[0], vb, pa0, pa1, pa2, pa3); pv_one<1>(o[1], vb, pa0, pa1, pa2, pa3); pv_one<2>(o[2], vb, pa0, pa1, pa2, pa3); pv_one<3>(o[3], vb, pa0, pa1, pa2, pa3);
}

template <typename TQ, bool FIXED>
__device__ __forceinline__ void attn_dense_body(const TQ* __restrict__ Qb, const bf16* __restrict__ Kh, const bf16* __restrict__ Vh,
                                                unsigned short* __restrict__ Ob, int seq, char* lds) {
  using St = Stage<bf16>; using SQ = Stage<TQ>;
  int tid_o = threadIdx.x; asm volatile("" : "+v"(tid_o));
  const int tid = tid_o, wid = tid >> 6, lane = tid & 63, r32 = lane & 31, hi = lane >> 5;
  bf16* V_lds = (bf16*)lds; bf16* K_lds = (bf16*)(lds + 2 * SHM_V);
  float* ws = (float*)(lds + 2 * SHM_V + 2 * SHM_K) + wid * 64; float* li_l = ws; float* al_l = ws + 32;
  float m_reg = -1e30f, l_reg = 0; f32x16 o[4] = {}; bf16x8 qr[8];
  const TQ* Qw = Qb + (long)(wid * QBLK + r32) * LDQ + hi * 8;
#pragma unroll
  for (int d0 = 0; d0 < 8; ++d0) qr[d0] = SQ::tobf(SQ::ld8(Qw + d0 * 16));
  const int sr = tid >> 4, sc = (tid & 15) * 8, vst0 = v_st(sr, sc), vst1 = v_st(32 + sr, sc);
  const int vb0 = (int)(uintptr_t)V_lds + v_rd_base(lane);
  struct { typename St::T vs0, vs1, ks0, ks1; } sr_[SDEPTH];
#define SLOAD(i, k0) do { sr_[i].vs0 = St::ld8(&Vh[(long)((k0) + sr) * LDK + sc]); sr_[i].vs1 = St::ld8(&Vh[(long)((k0) + 32 + sr) * LDK + sc]); \
    sr_[i].ks0 = St::ld8(&Kh[(long)((k0) + sr) * LDK + sc]); sr_[i].ks1 = St::ld8(&Kh[(long)((k0) + 32 + sr) * LDK + sc]); } while (0)
#define SWRITE(b, i) do { *(bf16x8*)((char*)V_lds + (b) * SHM_V + vst0) = St::tobf(sr_[i].vs0);          \
    *(bf16x8*)((char*)V_lds + (b) * SHM_V + vst1) = St::tobf(sr_[i].vs1); int kc = sc * 2;               \
    *(bf16x8*)((char*)K_lds + (b) * SHM_K + KSWZ(sr, kc)) = St::tobf(sr_[i].ks0);                       \
    *(bf16x8*)((char*)K_lds + (b) * SHM_K + KSWZ(32 + sr, kc)) = St::tobf(sr_[i].ks1); } while (0)
#define SWAIT() do { if constexpr (SDEPTH == 2) asm volatile("s_waitcnt vmcnt(4)" ::: "memory"); else asm volatile("s_waitcnt vmcnt(0)" ::: "memory"); } while (0)
#define RESC(a) do { if (__any((a) < 1.f)) { if (hi == 0) al_l[r32] = (a); asm volatile("s_waitcnt lgkmcnt(0)" ::: "memory"); \
    for (int d = 0; d < 4; ++d) for (int r = 0; r < 16; ++r) o[d][r] *= al_l[crow(r, hi)]; } } while (0)
#define PSM(P0, P1, MN, AL) do { if constexpr (FIXED) { partialSM_fixed(P0, P1); AL = 1.f; MN = 0.f; } else partialSM(P0, P1, m_reg, MN, AL); } while (0)
  f32x16 pA0, pA1, pB0, pB1; float mnA, mnB, alA, alB; bf16x8 pa0, pa1, pa2, pa3; const int NT = seq / KVBLK;
  constexpr int SE = 0, SO = SDEPTH - 1;
  SLOAD(SE, 0); asm volatile("s_waitcnt vmcnt(0)" ::: "memory"); SWRITE(0, SE); __syncthreads();
  qkt(pA0, pA1, K_lds, qr, r32, hi); PSM(pA0, pA1, mnA, alA);
  SLOAD(SO, KVBLK); if constexpr (SDEPTH == 2) { if (2 < NT) SLOAD(SE, 2 * KVBLK); }
  SWAIT(); SWRITE(1, SO); __syncthreads();
  for (int j = 1; j + 1 < NT; j += 2) {
    SBAR(); qkt(pB0, pB1, (bf16*)((char*)K_lds + SHM_K), qr, r32, hi);
    finishSM(pA0, pA1, alA, l_reg, pa0, pa1, pa2, pa3); SBAR();
    SLOAD(SO, (j + SDEPTH) * KVBLK); SBAR();
    pv_d0(o, vb0, pa0, pa1, pa2, pa3); PSM(pB0, pB1, mnB, alB);
    __syncthreads(); SWAIT(); SWRITE(0, SE);
    RESC(alB); __syncthreads();
    SBAR(); qkt(pA0, pA1, K_lds, qr, r32, hi);
    finishSM(pB0, pB1, alB, l_reg, pa0, pa1, pa2, pa3); SBAR();
    if (SDEPTH == 1 || j + 3 < NT) SLOAD(SE, (j + 1 + SDEPTH) * KVBLK); SBAR();
    pv_d0(o, vb0 + (int)SHM_V, pa0, pa1, pa2, pa3); PSM(pA0, pA1, mnA, alA);
    __syncthreads(); SWAIT(); SWRITE(1, SO);
    RESC(alA); __syncthreads();
  }
  SBAR(); qkt(pB0, pB1, (bf16*)((char*)K_lds + SHM_K), qr, r32, hi);
  finishSM(pA0, pA1, alA, l_reg, pa0, pa1, pa2, pa3); SBAR();
  pv_d0(o, vb0, pa0, pa1, pa2, pa3); PSM(pB0, pB1, mnB, alB);
  __syncthreads(); RESC(alB);
  finishSM(pB0, pB1, alB, l_reg, pa0, pa1, pa2, pa3); SBAR();
  pv_d0(o, vb0 + (int)SHM_V, pa0, pa1, pa2, pa3);
  if (hi == 0) li_l[r32] = l_reg; asm volatile("s_waitcnt lgkmcnt(0)" ::: "memory");
  float rli[16];
#pragma unroll
  for (int r = 0; r < 16; ++r) rli[r] = __builtin_amdgcn_rcpf(li_l[crow(r, hi)]);
  unsigned short* Ow = Ob + (long)(wid * QBLK) * LDO;
#pragma unroll
  for (int r = 0; r < 16; ++r) { int orow = crow(r, hi);
    for (int d0 = 0; d0 < 4; ++d0) Ow[(long)orow * LDO + d0 * 32 + r32] = f2bf_rne(o[d0][r] * rli[r]); }
#undef SLOAD
#undef SWRITE
#undef SWAIT
#undef RESC
#undef PSM
}
}

constexpr int DM = 2048, NBATCH = 4, SEQ = 4096, CTXL = 256, DEPTH = 4;
constexpr int ML = NBATCH * SEQ, MC = NBATCH * CTXL, MT = ML + MC;
constexpr int NINP = 4608;
constexpr int FF = 5504, FF2 = 11008, NMODV = 12288;
constexpr int SKV = SEQ + CTXL;
constexpr float EPS = 1e-6f;
constexpr int PC_QKV = 0, PC_Z = 1536, PC_GQ = 2048, PC_GK = 3072, PC_GV = 3328, PC_LX = 3584, PC_LG = 4096, PC_SM = 4608;
constexpr int NCHUNK = MT / 64;
constexpr int NGTASK = NCHUNK * 8;

constexpr size_t MiB = 1u << 20;
constexpr size_t WS_CTL = 0, CTL_ZERO_BYTES = 1 * MiB;
constexpr size_t WS_MOD = 1 * MiB, WS_ROPE = 2 * MiB, WS_MODP = 3 * MiB;
constexpr size_t WS_WIN = 11 * MiB, WS_WOUT = 30 * MiB, WS_WUP = 38 * MiB, WS_WDN = 81 * MiB;
constexpr size_t WS_X = 103 * MiB, WS_H = 239 * MiB, WS_Y = 307 * MiB, WS_QB = 375 * MiB, WS_KB = 409 * MiB, WS_VB = 418 * MiB;
constexpr size_t WS_BIG = 427 * MiB;
constexpr size_t WS_P = WS_BIG, WS_PS = WS_BIG + 160 * MiB, WS_QKVC = WS_BIG + 324 * MiB, WS_LAB = WS_BIG + 426 * MiB, WS_GT = WS_BIG + 428 * MiB, WS_GG = WS_BIG + 616 * MiB;
constexpr size_t WS_OF = WS_BIG + 617 * MiB, WS_OB = WS_BIG + 651 * MiB, WS_XC = WS_BIG + 685 * MiB, WS_LA = WS_BIG + 719 * MiB, WS_LU = WS_BIG + 787 * MiB;
constexpr size_t WS_LCT = WS_BIG + 855 * MiB, WS_LCI = WS_BIG + 858 * MiB, WS_MIX_END = WS_BIG + 860 * MiB;
constexpr int GT_NW = 0, GT_QD = 16384, GT_KT = 32768, GT_AT = 49152, GT_UT = 57344, GT_BYTES = 73728;
constexpr size_t WS_U = WS_BIG, WS_A = WS_BIG + 366 * MiB, WS_FFN_END = WS_BIG + 549 * MiB;
constexpr size_t WS_WSET1 = WS_MIX_END;
constexpr size_t WS_SLAB = WS_WSET1 + 92 * MiB;
constexpr size_t WS_END = WS_SLAB + 64 * MiB;
constexpr size_t WS_GWT = WS_WDN + 22 * MiB - 512 * 1024;
constexpr int NINW = 4672;
static_assert((size_t)MT * NINP * 2 <= 160 * MiB && (size_t)MT * 1536 * 4 <= 102 * MiB && (size_t)NGTASK * GT_BYTES <= 188 * MiB && (size_t)NGTASK * 65 * 4 <= 1 * MiB, "ws map");
static_assert((size_t)MT * FF2 * 2 <= 366 * MiB && (size_t)MT * FF * 2 <= 183 * MiB && (size_t)2 * MT * 512 * 4 <= 68 * MiB, "ws map");
static_assert((size_t)NINW * DM * 2 <= 19 * MiB && WS_WDN + 22 * MiB - WS_WIN <= 92 * MiB && (size_t)DM * FF * 2 <= 22 * MiB - 512 * 1024 && (size_t)FF2 * DM * 2 <= 43 * MiB && (size_t)DM * FF * 2 <= 22 * MiB && (size_t)8 * 4 * 5 * NMODV * 4 <= 8 * MiB, "ws map");
constexpr int CW_TMO = 0, CW_CODE = 1, CW_BAR = 4096;

constexpr int LDS_BYTES = 163840;
constexpr int MISC_OFF = LDS_BYTES - 256;
constexpr int PH_LDS = MISC_OFF;

#define GAS __attribute__((address_space(1)))
#define LAS __attribute__((address_space(3)))
#define DI __device__ __forceinline__
typedef unsigned short bf16;
typedef unsigned v4u __attribute__((ext_vector_type(4)));
typedef unsigned v2u __attribute__((ext_vector_type(2)));
typedef float f32x4 __attribute__((ext_vector_type(4)));
typedef float f32x2 __attribute__((ext_vector_type(2)));
typedef float f32x16 __attribute__((ext_vector_type(16)));
typedef short bf16x8 __attribute__((ext_vector_type(8)));
typedef GAS unsigned gu32;
#define RLX_AGENT __ATOMIC_RELAXED, __HIP_MEMORY_SCOPE_AGENT
#define LDS_WAIT() asm volatile("s_waitcnt lgkmcnt(0)" ::: "memory")
#define VM_WAIT() asm volatile("s_waitcnt vmcnt(0)" ::: "memory")
#define BAR_LDS() do { asm volatile("s_waitcnt lgkmcnt(0)" ::: "memory"); __builtin_amdgcn_s_barrier(); asm volatile("" ::: "memory"); } while (0)
DI unsigned f2bf(float f) { unsigned u = __builtin_bit_cast(unsigned, f); return (u + 0x7fffu + ((u >> 16) & 1u)) >> 16; }
typedef __bf16 bf16x2v __attribute__((ext_vector_type(2)));
DI unsigned pk2(float lo, float hi) { f32x2 v = {lo, hi}; bf16x2v r = __builtin_convertvector(v, bf16x2v); return __builtin_bit_cast(unsigned, r); }
DI float bf_lo(unsigned w) { return __builtin_bit_cast(float, w << 16); }
DI float bf_hi(unsigned w) { return __builtin_bit_cast(float, w & 0xffff0000u); }

#define XB_TMO      128
#define XB_XCNT(j)  (256  + 64 * (j))
#define XB_XSUB(j)  (1280 + 64 * (j))
#define XB_XGEN(j)  (2304 + 64 * (j))
#define XB_TOP      3328
#define XB_TOPGEN   3392
#define XCD_BAR_WORDS 3456
#define XB_SPIN_CAP (1u << 18)

__device__ __forceinline__ unsigned xb_ld(unsigned* p)              { return __hip_atomic_load(p, __ATOMIC_RELAXED, __HIP_MEMORY_SCOPE_AGENT); }
__device__ __forceinline__ unsigned xb_add(unsigned* p, unsigned v) { return __hip_atomic_fetch_add(p, v, __ATOMIC_RELAXED, __HIP_MEMORY_SCOPE_AGENT); }
__device__ __forceinline__ unsigned xb_xcc_id() { return (unsigned)__builtin_amdgcn_s_getreg((3 << 11) | 20) & 0xFu; }
#define XB_SPIN(cond, bar) do { unsigned _sp = 0; while (cond) { __builtin_amdgcn_s_sleep(1); \
    if ((++_sp & 255u) == 0u) { if (xb_ld(&(bar)[XB_TMO])) break; if (_sp > XB_SPIN_CAP) { atomicAdd(&(bar)[XB_TMO], 1u); break; } } } } while (0)

struct XcdBarrier {
    unsigned* bar; unsigned x;
    volatile LAS unsigned* st;
};
__device__ __forceinline__ XcdBarrier xcd_barrier_post(unsigned* bar, volatile LAS unsigned* st) {
    XcdBarrier b; b.bar = bar; b.x = xb_xcc_id(); b.st = st;
    if (threadIdx.x == 0) (void)xb_add(&bar[XB_XCNT(b.x)], 1u);
    return b;
}
__device__ __forceinline__ void xcd_barrier_complete(unsigned* bar, unsigned x, unsigned& nloc, unsigned& nx) {
    const unsigned G = gridDim.x * gridDim.y * gridDim.z;
    unsigned sum, cnt, mine, sp = 0u;
    for (;;) {
        sum = 0u; cnt = 0u; mine = 0u;
#pragma unroll
        for (unsigned j = 0; j < 16; ++j) { const unsigned c = xb_ld(&bar[XB_XCNT(j)]); sum += c; cnt += (c > 0u) ? 1u : 0u; mine = (j == x) ? c : mine; }
        if (sum == G) break;
        __builtin_amdgcn_s_sleep(1);
        if ((++sp & 255u) == 0u) { if (xb_ld(&bar[XB_TMO])) break; if (sp > XB_SPIN_CAP) { atomicAdd(&bar[XB_TMO], 1u); break; } }
    }
    nloc = mine > 0u ? mine : 1u; nx = cnt > 0u ? cnt : 1u;
}
__device__ __forceinline__ void xcd_barrier(const XcdBarrier& b) {
    asm volatile("s_waitcnt vmcnt(0)" ::: "memory");
    __syncthreads();
    if (threadIdx.x == 0) {
        unsigned* bar = b.bar;
        __builtin_amdgcn_s_waitcnt(0);
        unsigned nloc = b.st[0], nx = b.st[1];
        if (nloc == 0u) { xcd_barrier_complete(bar, b.x, nloc, nx); b.st[0] = nloc; b.st[1] = nx; }
        const unsigned old = xb_add(&bar[XB_XSUB(b.x)], 1u);
        const unsigned gen = old / nloc;
        if (old + 1u == (gen + 1u) * nloc) {
            __builtin_amdgcn_fence(__ATOMIC_RELEASE, "agent");
            asm volatile("s_waitcnt vmcnt(0)" ::: "memory");
            const unsigned og = xb_add(&bar[XB_TOP], 1u);
            const unsigned tg = og / nx;
            if (og + 1u == (tg + 1u) * nx) xb_add(&bar[XB_TOPGEN], 1u);
            else XB_SPIN(xb_ld(&bar[XB_TOPGEN]) == tg, bar);
            __builtin_amdgcn_fence(__ATOMIC_ACQUIRE, "agent");
            xb_add(&bar[XB_XGEN(b.x)], 1u);
            asm volatile("s_waitcnt vmcnt(0)" ::: "memory");
        } else {
            XB_SPIN(xb_ld(&bar[XB_XGEN(b.x)]) == gen, bar);
            __builtin_amdgcn_fence(__ATOMIC_ACQUIRE, "agent");
            asm volatile("s_waitcnt vmcnt(0)" ::: "memory");
        }
    }
    __syncthreads();
}

DI float wave_sum(float v) {
#pragma unroll
    for (int o = 1; o < 64; o <<= 1) v += __shfl_xor(v, o);
    return v;
}
DI float fexp_(float x) { return __builtin_amdgcn_exp2f(x * 1.4426950408889634f); }
DI float frcp_(float x) { return __builtin_amdgcn_rcpf(x); }
DI float sigmoidf_(float x) { return frcp_(1.0f + fexp_(-x)); }
DI float siluf_(float x) { return x * frcp_(1.0f + fexp_(-x)); }
DI float softplusf_(float x) { return fmaxf(x, 0.0f) + log1pf(expf(-fabsf(x))); }
DI float gelu_tanhf_(float x) { const float y = 0.7978845608028654f * (x + 0.044715f * x * x * x); const float t = 1.0f - 2.0f * frcp_(1.0f + fexp_(2.0f * y)); return 0.5f * x * (1.0f + t); }
struct RowInfo { int b, t, T; };
DI RowInfo row_info(int m) { RowInfo r; if (m < ML) { r.b = m >> 12; r.t = m & 4095; r.T = SEQ; } else { const int mm = m - ML; r.b = mm >> 8; r.t = mm & 255; r.T = CTXL; } return r; }
DI int chain_chunk(int b, int dir, int k) { return dir == 0 ? (k < 4 ? 256 + b * 4 + k : b * 64 + (k - 4)) : (k < 4 ? 256 + b * 4 + (3 - k) : b * 64 + (63 - (k - 4))); }
DI void sincos_d(float ang, float& s, float& c) {
    const double a = (double)ang; const double k = __builtin_rint(a * 0.15915494309189535); const double r = a - k * 6.283185307179586477;
    const double r2 = r * r; double ts = r, tc = 1.0, ss = r, cc = 1.0;
#pragma unroll
    for (int n = 1; n <= 14; ++n) { tc = -tc * r2 / (double)((2 * n - 1) * (2 * n)); cc += tc; ts = -ts * r2 / (double)((2 * n) * (2 * n + 1)); ss += ts; }
    s = (float)ss; c = (float)cc;
}
DI int gperm16(int kk) { return ((kk >> 2) & 1) * 8 + (kk >> 3) * 4 + (kk & 3); }
DI int gperm(int k) { return (k & ~15) | gperm16(k & 15); }
DI int crow32(int r, int hf) { return (r & 3) + 8 * (r >> 2) + 4 * hf; }
DI bf16x8 pack_acc(const f32x16& x, int s) { v4u w; w.x = pk2(x[8 * s + 0], x[8 * s + 1]); w.y = pk2(x[8 * s + 2], x[8 * s + 3]); w.z = pk2(x[8 * s + 4], x[8 * s + 5]); w.w = pk2(x[8 * s + 6], x[8 * s + 7]); return __builtin_bit_cast(bf16x8, w); }

DI void ph_prologue_a(const float* x, const float* ctx, const float* c, const float* cctx, const float* ada_w, bf16* X, float* ROPE, float* MODP,
                      LAS unsigned char* lds, int bid, int G, int tid) {
    const size_t nx8 = (size_t)ML * DM / 8, nc8 = (size_t)MC * DM / 8;
    for (size_t i = (size_t)bid * 512 + tid; i < nx8 + nc8; i += (size_t)G * 512) {
        const f32x4* src = i < nx8 ? (const f32x4*)x + 2 * i : (const f32x4*)ctx + 2 * (i - nx8);
        const f32x4 v0 = __builtin_nontemporal_load(src), v1 = __builtin_nontemporal_load(src + 1);
        v4u o; o.x = pk2(v0.x, v0.y); o.y = pk2(v0.z, v0.w); o.z = pk2(v1.x, v1.y); o.w = pk2(v1.z, v1.w);
        ((v4u*)X)[i] = o; }
    { const int idx = bid * 512 + tid;
      if (idx < 64 * 32) { const int pos = idx >> 5, f = idx & 31;
          double inv = 1.0; for (int j = 0; j < f; ++j) inv *= 0.74989420933245582730;
          const float ang = (float)pos * (float)inv; float s, cc; sincos_d(ang, s, cc); ROPE[idx * 2] = cc; ROPE[idx * 2 + 1] = s; } }
    LAS float* sl = (LAS float*)lds;
    for (int it = bid; it < 4 * 8 * 24; it += G) {
        const int L = it / 192, r = it % 192, kc = r / 24, nb = r % 24, n = nb * 512 + tid, k0 = kc * 256;
        __syncthreads();
        for (int e = tid; e < 5 * 256; e += 512) { const int i = e >> 8, kk = e & 255; const float cv = i < 4 ? c[i * DM + k0 + kk] : cctx[k0 + kk]; sl[e] = siluf_(cv); }
        __syncthreads();
        float acc[5] = {0.f, 0.f, 0.f, 0.f, 0.f};
        const float* wp = ada_w + ((size_t)L * DM + k0) * NMODV + n;
#pragma unroll 16
        for (int kk = 0; kk < 256; ++kk) { const float w = __builtin_nontemporal_load(wp + (size_t)kk * NMODV);
#pragma unroll
            for (int i = 0; i < 5; ++i) acc[i] += sl[i * 256 + kk] * w; }
#pragma unroll
        for (int i = 0; i < 5; ++i) MODP[((size_t)(kc * 4 + L) * 5 + i) * NMODV + n] = acc[i];
    }
}
DI void ph_prologue_b(const float* ada_b, const float* MODP, float* MOD, int bid, int G, int tid) {
    for (int idx = bid * 512 + tid; idx < 4 * 5 * NMODV; idx += G * 512) {
        const int L = idx / (5 * NMODV), n = idx % NMODV; float s = ada_b[L * NMODV + n];
#pragma unroll
        for (int kc = 0; kc < 8; ++kc) s += MODP[(size_t)kc * (4 * 5 * NMODV) + idx];
        MOD[idx] = s; }
}
template <int MAP> DI void transpose_item(const float* W, int K, int Nsrc, bf16* WT, LAS float* scr, int item, int nblk, int lane) {
    const int kb = item / nblk, nb = item % nblk, k0 = 64 * kb, n0 = 64 * nb;
    const int np = n0 + lane;
    const int col = MAP == 1 ? (np < 2048 ? np : (np < 4608 ? np + 16 : (np < 4624 ? np - 2560 : -1))) : (MAP == 2 ? ((np >> 7) & 1) * FF + (np >> 8) * 128 + (np & 127) : np);
    const float* src = W + (size_t)k0 * Nsrc + (col >= 0 ? col : 0);
#pragma unroll
    for (int h = 0; h < 2; ++h) { float v[32];
#pragma unroll
        for (int i = 0; i < 32; ++i) v[i] = __builtin_nontemporal_load(src + (size_t)(32 * h + i) * Nsrc);
#pragma unroll
        for (int i = 0; i < 32; ++i) scr[(32 * h + i) * 65 + lane] = col >= 0 ? v[i] : 0.f; }
    LDS_WAIT(); asm volatile("" ::: "memory");
    const int c = lane & 7;
#pragma unroll
    for (int j = 0; j < 8; ++j) { const int n = (lane >> 3) + 8 * j; const LAS float* s = scr + (8 * c) * 65 + n;
        v4u o; o.x = pk2(s[0 * 65], s[1 * 65]); o.y = pk2(s[2 * 65], s[3 * 65]); o.z = pk2(s[4 * 65], s[5 * 65]); o.w = pk2(s[6 * 65], s[7 * 65]);
        __builtin_nontemporal_store(o, (v4u*)(WT + (size_t)(n0 + n) * K + k0 + 8 * c)); }
    LDS_WAIT(); asm volatile("" ::: "memory");
}
DI void ph_wconv(const float* w_in, const float* w_out, const float* w_up, const float* w_dn, const float* gate_w, bf16* WIN, bf16* WOUT, bf16* WUP, bf16* WDN, bf16* GWT,
                 LAS unsigned char* lds, int gw, int ngw, int wave, int lane) {
    for (int idx = gw * 64 + lane; idx < 2 * 2 * 8 * 64 * 64; idx += ngw * 64) { const int dd = idx & 63, e = (idx >> 6) & 63, hi = idx >> 12; GWT[idx] = (bf16)f2bf(gate_w[(size_t)hi * 4096 + dd * 64 + e]); }
    LAS float* scr = (LAS float*)(lds + wave * 16640);
    constexpr int I_IN = (DM / 64) * (NINW / 64), I_OUT = (DM / 64) * (DM / 64), I_UP = (DM / 64) * (FF2 / 64), I_DN = (FF / 64) * (DM / 64);
    for (int it = gw; it < I_IN + I_OUT + I_UP + I_DN; it += ngw) {
        int r = it;
        if (r < I_IN) { transpose_item<1>(w_in, DM, 4624, WIN, scr, r, NINW / 64, lane); continue; } r -= I_IN;
        if (r < I_OUT) { transpose_item<0>(w_out, DM, DM, WOUT, scr, r, DM / 64, lane); continue; } r -= I_OUT;
        if (r < I_UP) { transpose_item<2>(w_up, DM, FF2, WUP, scr, r, FF2 / 64, lane); continue; } r -= I_UP;
        transpose_item<0>(w_dn, FF, DM, WDN, scr, r, DM / 64, lane);
    }
}
struct NormLd { v4u xb[4]; };
DI void norm_issue(NormLd& L, const bf16* X, int m, int lane) {
    const v4u* xr = (const v4u*)(X + (size_t)m * DM) + lane;
#pragma unroll
    for (int j = 0; j < 4; ++j) L.xb[j] = xr[64 * j];
    asm volatile("" ::: "memory");
}
DI void norm_row(const NormLd& L, int m, bf16* X, const float* g, const float* modL, int shoff, int scoff, bf16* H, const bf16* slab, int lane) {
    {
        const int bidx = m < ML ? (m >> 12) : 4; const float* mod = modL + (size_t)bidx * NMODV;
        v4u* xr = (v4u*)(X + (size_t)m * DM) + lane;
        v4u xb[4]; f32x4 v[8]; float ss = 0.f;
#pragma unroll
        for (int j = 0; j < 4; ++j) xb[j] = L.xb[j];
#pragma unroll
        for (int j = 0; j < 4; ++j) { v[2 * j] = (f32x4){bf_lo(xb[j].x), bf_hi(xb[j].x), bf_lo(xb[j].y), bf_hi(xb[j].y)}; v[2 * j + 1] = (f32x4){bf_lo(xb[j].z), bf_hi(xb[j].z), bf_lo(xb[j].w), bf_hi(xb[j].w)}; }
        if (slab != nullptr && m >= ML) {
#pragma unroll
            for (int p = 0; p < 8; p += 4) { const v4u* s0 = (const v4u*)(slab + ((size_t)p * 1024 + (m - ML)) * DM) + lane;
                v4u t[4][4];
#pragma unroll
                for (int q = 0; q < 4; ++q)
#pragma unroll
                    for (int j = 0; j < 4; ++j) t[q][j] = __builtin_nontemporal_load(s0 + (size_t)q * (1024 * DM / 8) + 64 * j);
#pragma unroll
                for (int q = 0; q < 4; ++q)
#pragma unroll
                    for (int j = 0; j < 4; ++j) { v[2 * j] += (f32x4){bf_lo(t[q][j].x), bf_hi(t[q][j].x), bf_lo(t[q][j].y), bf_hi(t[q][j].y)}; v[2 * j + 1] += (f32x4){bf_lo(t[q][j].z), bf_hi(t[q][j].z), bf_lo(t[q][j].w), bf_hi(t[q][j].w)}; } }
#pragma unroll
            for (int j = 0; j < 4; ++j) { v4u o; o.x = pk2(v[2 * j].x, v[2 * j].y); o.y = pk2(v[2 * j].z, v[2 * j].w); o.z = pk2(v[2 * j + 1].x, v[2 * j + 1].y); o.w = pk2(v[2 * j + 1].z, v[2 * j + 1].w); xr[64 * j] = o; } }
#pragma unroll
        for (int j = 0; j < 8; ++j) ss += (v[j].x * v[j].x + v[j].y * v[j].y) + (v[j].z * v[j].z + v[j].w * v[j].w);
        f32x4 gg[8], sc[8], sh[8];
#pragma unroll
        for (int j = 0; j < 8; ++j) { const int col = 512 * (j >> 1) + 8 * lane + 4 * (j & 1); gg[j] = *(const f32x4*)(g + col); sc[j] = *(const f32x4*)(mod + scoff + col); sh[j] = *(const f32x4*)(mod + shoff + col); }
        const float rstd = 1.0f / sqrtf(wave_sum(ss) * (1.0f / DM) + EPS);
        v4u* o16 = (v4u*)(H + (size_t)m * DM) + lane;
#pragma unroll
        for (int j = 0; j < 4; ++j) { const f32x4 y0 = (v[2 * j] * rstd * gg[2 * j]) * (sc[2 * j] + 1.0f) + sh[2 * j], y1 = (v[2 * j + 1] * rstd * gg[2 * j + 1]) * (sc[2 * j + 1] + 1.0f) + sh[2 * j + 1];
            v4u o; o.x = pk2(y0.x, y0.y); o.y = pk2(y0.z, y0.w); o.z = pk2(y1.x, y1.y); o.w = pk2(y1.z, y1.w); o16[64 * j] = o; }
    }
}
DI void ph_norm_mod(bf16* X, const float* g, const float* modL, int shoff, int scoff, bf16* H, int Mrows, const bf16* slab, int gw, int ngw, int lane) {
    NormLd A, B; int m = gw;
    if (m < Mrows) norm_issue(A, X, m, lane);
    for (; m < Mrows; m += 2 * ngw) { const int m2 = m + ngw, m3 = m2 + ngw;
        if (m2 < Mrows) norm_issue(B, X, m2, lane);
        norm_row(A, m, X, g, modL, shoff, scoff, H, slab, lane);
        if (m3 < Mrows) norm_issue(A, X, m3, lane);
        if (m2 < Mrows) norm_row(B, m2, X, g, modL, shoff, scoff, H, slab, lane);
    }
}
DI void unpack8(const v4u x, float (&f)[8]) { f[0] = bf_lo(x.x); f[1] = bf_hi(x.x); f[2] = bf_lo(x.y); f[3] = bf_hi(x.y); f[4] = bf_lo(x.z); f[5] = bf_hi(x.z); f[6] = bf_lo(x.w); f[7] = bf_hi(x.w); }
struct TokLd { v4u rq1, rq2, rk1, rk2; v2u rv; float b_raw, a_raw; f32x4 rp[4]; };
DI void tok_issue(TokLd& L, int m, const bf16* P, const float* PS, const float* ROPE, int offq, int offk, int a, int j4, int lane) {
    const RowInfo ri = row_info(m); const bf16* pr = P + (size_t)m * NINP;
    L.rq1 = __builtin_nontemporal_load((const v4u*)(pr + PC_GQ + offq)); L.rq2 = __builtin_nontemporal_load((const v4u*)(pr + PC_GQ + offq + 32));
    L.rk1 = __builtin_nontemporal_load((const v4u*)(pr + PC_GK + offk)); L.rk2 = __builtin_nontemporal_load((const v4u*)(pr + PC_GK + offk + 32));
    L.rv = __builtin_nontemporal_load((const v2u*)(pr + PC_GV + 4 * lane));
    L.b_raw = 0.f; L.a_raw = 0.f;
    if (lane < 8) { L.b_raw = PS[(size_t)m * 16 + lane]; L.a_raw = PS[(size_t)m * 16 + 8 + lane]; }
    const int pos = m < ML ? (a ? (ri.t & 63) : (ri.t >> 6)) : 0;
#pragma unroll
    for (int e = 0; e < 4; ++e) L.rp[e] = *(const f32x4*)(ROPE + (pos * 32 + 8 * j4 + 2 * e) * 2);
    asm volatile("" ::: "memory");
}
DI void tok_finish(const TokLd& L, int m, const f32x4 (&gl)[2][4], float nea, float dtb, float* LAB, bf16* QB, bf16* KB, bf16* VB, int offq, int offk, int lane) {
    const RowInfo ri = row_info(m); const bool lat = m < ML;
    if (lane < 8) { LAB[(size_t)m * 16 + lane] = nea * softplusf_(L.a_raw + dtb); LAB[(size_t)m * 16 + 8 + lane] = sigmoidf_(L.b_raw); }
    float cs_[8], sn_[8];
#pragma unroll
    for (int e = 0; e < 4; ++e) { cs_[2 * e] = L.rp[e].x; sn_[2 * e] = L.rp[e].y; cs_[2 * e + 1] = L.rp[e].z; sn_[2 * e + 1] = L.rp[e].w; }
    const int kvpos = lat ? ri.t : SEQ + ri.t;
#pragma unroll
    for (int part = 0; part < 2; ++part) {
        float x1[8], x2[8]; unpack8(part == 0 ? L.rq1 : L.rk1, x1); unpack8(part == 0 ? L.rq2 : L.rk2, x2);
        float ss = 0.f;
#pragma unroll
        for (int e = 0; e < 8; ++e) ss += x1[e] * x1[e] + x2[e] * x2[e];
        ss += __shfl_xor(ss, 1); ss += __shfl_xor(ss, 2); ss += __shfl_xor(ss, 4);
        const float rstd = __builtin_amdgcn_rsqf(ss * (1.0f / 128.0f) + EPS);
        const float g1[8] = {gl[part][0].x, gl[part][0].y, gl[part][0].z, gl[part][0].w, gl[part][1].x, gl[part][1].y, gl[part][1].z, gl[part][1].w};
        const float g2[8] = {gl[part][2].x, gl[part][2].y, gl[part][2].z, gl[part][2].w, gl[part][3].x, gl[part][3].y, gl[part][3].z, gl[part][3].w};
        float o1[8], o2[8];
        const float rs = part == 0 ? rstd * 0.12751743f : rstd;
#pragma unroll
        for (int e = 0; e < 8; ++e) { const float y1 = x1[e] * rs * g1[e], y2 = x2[e] * rs * g2[e]; o1[e] = y1 * cs_[e] - y2 * sn_[e]; o2[e] = y2 * cs_[e] + y1 * sn_[e]; }
        bf16* dst = part == 0 ? QB + (size_t)m * 1024 + offq : KB + ((size_t)ri.b * SKV + kvpos) * 256 + offk;
        if (part == 0 || lane < 16) { v4u w1, w2; w1.x = pk2(o1[0], o1[1]); w1.y = pk2(o1[2], o1[3]); w1.z = pk2(o1[4], o1[5]); w1.w = pk2(o1[6], o1[7]);
            w2.x = pk2(o2[0], o2[1]); w2.y = pk2(o2[2], o2[3]); w2.z = pk2(o2[4], o2[5]); w2.w = pk2(o2[6], o2[7]); *(v4u*)dst = w1; *(v4u*)(dst + 32) = w2; }
    }
    *(v2u*)(VB + ((size_t)ri.b * SKV + kvpos) * 256 + 4 * lane) = L.rv;
}
DI void ph_tokprep(const bf16* P, const float* PS, const float* gconv_w, const float* a_log, const float* dt_bias, const float* qg, const float* kg, const float* ROPE,
                   const float* lconv_w, const float* lconv_b, bf16* QKVC, float* LAB, bf16* QB, bf16* KB, bf16* VB, float* XC, int gw, int ngw, int lane) {
    constexpr int SEG = 34, NSEG = MT / SEG;
    static_assert(NSEG * SEG == MT, "segments");
    for (int it = gw; it < 4 * NSEG; it += ngw) {
        const int cs = it & 3, m0 = (it >> 2) * SEG;
        const bf16* pc = P + (cs < 3 ? PC_QKV + cs * 512 : PC_LX) + 8 * lane;
        const float* wsrc = cs < 3 ? gconv_w + cs * 512 + 8 * lane : lconv_w + 8 * lane; const int wstr = cs < 3 ? 1536 : 512;
        float w[4][8], bias[8];
#pragma unroll
        for (int j = 0; j < 4; ++j) { const f32x4 a = *(const f32x4*)(wsrc + j * wstr), b = *(const f32x4*)(wsrc + j * wstr + 4); w[j][0] = a.x; w[j][1] = a.y; w[j][2] = a.z; w[j][3] = a.w; w[j][4] = b.x; w[j][5] = b.y; w[j][6] = b.z; w[j][7] = b.w; }
#pragma unroll
        for (int e = 0; e < 8; ++e) bias[e] = cs == 3 ? lconv_b[8 * lane + e] : 0.f;
        const v4u z4 = {0u, 0u, 0u, 0u};
#define LDROW(row) (((row) >= 0 && (row) < MT) ? __builtin_nontemporal_load((const v4u*)(pc + (size_t)(row) * NINP)) : z4)
        v4u w0 = LDROW(m0 - 2), w1 = LDROW(m0 - 1), w2 = LDROW(m0), cur[8], nxt[8];
#pragma unroll
        for (int i = 0; i < 8; ++i) cur[i] = LDROW(m0 + 1 + i);
#pragma unroll 1
        for (int r0 = 0; r0 < SEG; r0 += 8) {
#pragma unroll
            for (int i = 0; i < 8; ++i) nxt[i] = (r0 + 8 + i < SEG) ? LDROW(m0 + r0 + 9 + i) : z4;
#pragma unroll
            for (int i = 0; i < 8; ++i) { if (r0 + i < SEG) { const int m = m0 + r0 + i; const RowInfo ri = row_info(m);
                const v4u w3 = cur[i];
                float acc[8], f[8];
#pragma unroll
                for (int e = 0; e < 8; ++e) acc[e] = bias[e];
                if (ri.t >= 2) { unpack8(w0, f);
#pragma unroll
                    for (int e = 0; e < 8; ++e) acc[e] += w[0][e] * f[e]; }
                if (ri.t >= 1) { unpack8(w1, f);
#pragma unroll
                    for (int e = 0; e < 8; ++e) acc[e] += w[1][e] * f[e]; }
                unpack8(w2, f);
#pragma unroll
                for (int e = 0; e < 8; ++e) acc[e] += w[2][e] * f[e];
                if (ri.t + 1 < ri.T) { unpack8(w3, f);
#pragma unroll
                    for (int e = 0; e < 8; ++e) acc[e] += w[3][e] * f[e]; }
                if (cs < 3) {
#pragma unroll
                    for (int e = 0; e < 8; ++e) acc[e] = siluf_(acc[e]);
                    if (cs < 2) { float ss = 0.f;
#pragma unroll
                        for (int e = 0; e < 8; ++e) ss += acc[e] * acc[e];
                        ss += __shfl_xor(ss, 1); ss += __shfl_xor(ss, 2); ss += __shfl_xor(ss, 4); ss += __shfl_xor(ss, 8);
                        float rn = __builtin_amdgcn_rsqf(ss + EPS); if (cs == 0) rn *= 0.08838834764831845f;
#pragma unroll
                        for (int e = 0; e < 8; ++e) acc[e] *= rn; }
                    v4u o; o.x = pk2(acc[0], acc[1]); o.y = pk2(acc[2], acc[3]); o.z = pk2(acc[4], acc[5]); o.w = pk2(acc[6], acc[7]);
                    *(v4u*)(QKVC + (size_t)m * 1536 + cs * 512 + 8 * lane) = o;
                } else { float* dst = XC + (size_t)m * 512 + 8 * lane;
                    *(f32x4*)dst = (f32x4){acc[0], acc[1], acc[2], acc[3]}; *(f32x4*)(dst + 4) = (f32x4){acc[4], acc[5], acc[6], acc[7]}; }
                w0 = w1; w1 = w2; w2 = w3; } }
#pragma unroll
            for (int i = 0; i < 8; ++i) cur[i] = nxt[i];
        }
#undef LDROW
    }
    { const int a = (lane >> 2) & 1, j4 = lane & 3;
      const int offq = (lane >> 3) * 128 + a * 64 + 8 * j4, offk = ((lane >> 3) & 1) * 128 + a * 64 + 8 * j4;
      f32x4 gl[2][4];
#pragma unroll
      for (int part = 0; part < 2; ++part) { const float* gn = (part == 0 ? qg : kg) + a * 64 + 8 * j4; gl[part][0] = *(const f32x4*)gn; gl[part][1] = *(const f32x4*)(gn + 4); gl[part][2] = *(const f32x4*)(gn + 32); gl[part][3] = *(const f32x4*)(gn + 36); }
      const float nea = -expf(a_log[lane & 7]), dtb = dt_bias[lane & 7];
      TokLd A, B; int m = gw;
      if (m < MT) tok_issue(A, m, P, PS, ROPE, offq, offk, a, j4, lane);
      for (; m < MT; m += 2 * ngw) { const int m2 = m + ngw, m3 = m2 + ngw;
          if (m2 < MT) tok_issue(B, m2, P, PS, ROPE, offq, offk, a, j4, lane);
          tok_finish(A, m, gl, nea, dtb, LAB, QB, KB, VB, offq, offk, lane);
          if (m3 < MT) tok_issue(A, m3, P, PS, ROPE, offq, offk, a, j4, lane);
          if (m2 < MT) tok_finish(B, m2, gl, nea, dtb, LAB, QB, KB, VB, offq, offk, lane);
      } }
}
DI void ph_small_cols(const bf16* H, const bf16* WIN, float* PS, int gw, int ngw, int lane) {
    const int r16 = lane & 15, q = lane >> 4;
    for (int tile = gw; tile < MT / 16; tile += ngw) {
        const bf16* ap = H + ((size_t)tile * 16 + r16) * DM + 8 * q; const bf16* bp = WIN + ((size_t)4608 + r16) * DM + 8 * q;
        f32x4 acc = {0.f, 0.f, 0.f, 0.f};
        for (int k0 = 0; k0 < DM / 32; k0 += 16) { bf16x8 a[16], b[16];
#pragma unroll
            for (int i = 0; i < 16; ++i) { a[i] = *(const bf16x8*)(ap + (k0 + i) * 32); b[i] = *(const bf16x8*)(bp + (k0 + i) * 32); }
#pragma unroll
            for (int i = 0; i < 16; ++i) acc = __builtin_amdgcn_mfma_f32_16x16x32_bf16(a[i], b[i], acc, 0, 0, 0); }
#pragma unroll
        for (int r = 0; r < 4; ++r) PS[((size_t)tile * 16 + 4 * q + r) * 16 + r16] = acc[r];
    }
}

struct GdnRegs { v4u qq[2], kq[2], vq[2]; float la, be; };
DI void gdn_issue(GdnRegs& R, int t2, const bf16* QKVC, const float* LAB, int tid) {
    const int h = t2 & 3, rb = (t2 >> 2) * 64; asm volatile("" : "+v"(tid));
#pragma unroll
    for (int e = 0; e < 2; ++e) { const int p = tid + 512 * e, a = ((p >> 2) & 15) + 16 * ((p >> 6) & 3), c8 = ((p & 3) + 4 * (p >> 8)) * 8; const bf16* src = QKVC + (size_t)(rb + a) * 1536 + h * 128 + c8;
        R.qq[e] = __builtin_nontemporal_load((const v4u*)src); R.kq[e] = __builtin_nontemporal_load((const v4u*)(src + 512)); R.vq[e] = __builtin_nontemporal_load((const v4u*)(src + 1024)); }
    R.la = 0.f; R.be = 0.f;
    if (tid < 128) { const int d = tid >> 6, a = tid & 63; R.la = LAB[(size_t)(rb + a) * 16 + d * 4 + h]; R.be = LAB[(size_t)(rb + a) * 16 + 8 + d * 4 + h]; }
}
DI void gdn_chunk_task(int t2, int t2next, GdnRegs& R, const bf16* QKVC, const float* LAB, unsigned char* GT, float* GG, LAS unsigned char* lds, int tid) {
    const int h = t2 & 3, sc = t2 >> 2;
    const int wave = __builtin_amdgcn_readfirstlane(tid >> 6), lane = tid & 63, c32 = lane & 31, hf = lane >> 5;
    LAS unsigned char* Kb = lds;
    LAS unsigned char* Qb = lds + 17408;
    LAS unsigned char* KTb = lds + 34816;
    LAS unsigned char* VTb = lds + 53248;
    LAS float* Lt = (LAS float*)(lds + 71680);
    LAS unsigned char* TVW = lds + 104448;
    LAS float* laS = (LAS float*)(lds + 141312);
    LAS float* beS = laS + 128;
    LAS float* GS = beS + 128;
    unsigned char* gt0 = GT + (size_t)(t2 * 2) * GT_BYTES; unsigned char* gt1 = gt0 + GT_BYTES;
    gdn_issue(R, t2, QKVC, LAB, tid); (void)t2next;
    if (tid < 128) { beS[tid] = R.be;
        const int d = tid >> 6, a = tid & 63; float g = R.la;
#pragma unroll
        for (int o = 1; o < 64; o <<= 1) { const float t = d == 0 ? __shfl_up(g, o) : __shfl_down(g, o); if (d == 0 ? (a >= o) : (a + o < 64)) g += t; }
        GS[tid] = g; }
    BAR_LDS();
    if (tid < 2) GG[t2 * 2 + tid] = expf(tid == 0 ? GS[63] : GS[64]);
#pragma unroll
    for (int e = 0; e < 2; ++e) { const int p = tid + 512 * e, a = ((p >> 2) & 15) + 16 * ((p >> 6) & 3), c8 = ((p & 3) + 4 * (p >> 8)) * 8; const v4u kw = R.kq[e], qw = R.qq[e], vw = R.vq[e];
        *(LAS v4u*)(Kb + a * 272 + c8 * 2) = kw; *(LAS v4u*)(Qb + a * 272 + c8 * 2) = qw;
#pragma unroll
        for (int q = 0; q < 8; ++q) { *(LAS bf16*)(KTb + (c8 + q) * 144 + a * 2) = (bf16)(kw[q >> 1] >> (16 * (q & 1))); *(LAS bf16*)(VTb + (c8 + q) * 144 + a * 2) = (bf16)(vw[q >> 1] >> (16 * (q & 1))); }
        float qf[8]; unpack8(qw, qf);
#pragma unroll
        for (int d = 0; d < 2; ++d) { const float s_ = fexp_(GS[d * 64 + a]); const int ip = d ? 63 - a : a; unsigned char* qd = (d ? gt1 : gt0) + GT_QD + (size_t)ip * 256;
            v2u o0, o1; o0.x = pk2(qf[0] * s_, qf[1] * s_); o0.y = pk2(qf[2] * s_, qf[3] * s_); o1.x = pk2(qf[4] * s_, qf[5] * s_); o1.y = pk2(qf[6] * s_, qf[7] * s_);
            *(v2u*)(qd + gperm(c8) * 2) = o0; *(v2u*)(qd + gperm(c8 + 4) * 2) = o1; } }
    BAR_LDS();
    if (wave < 7) {
        const bool isqk = wave >= 3; const int ta = isqk ? ((wave - 3) >> 1) : (wave > 0 ? 1 : 0), tb = isqk ? ((wave - 3) & 1) : (wave > 1 ? 1 : 0);
        f32x16 acc;
#pragma unroll
        for (int r = 0; r < 16; ++r) acc[r] = 0.f;
        const LAS unsigned char* ap = (isqk ? Qb : Kb) + (32 * ta + c32) * 272 + hf * 16; const LAS unsigned char* bp = Kb + (32 * tb + c32) * 272 + hf * 16;
#pragma unroll
        for (int s = 0; s < 8; ++s) acc = __builtin_amdgcn_mfma_f32_32x32x16_bf16(*(const LAS bf16x8*)(ap + 32 * s), *(const LAS bf16x8*)(bp + 32 * s), acc, 0, 0, 0);
        const int bt = 32 * tb + c32; const float G0b = GS[bt], G1b = GS[64 + bt], be1b = beS[64 + bt];
#pragma unroll
        for (int r = 0; r < 16; ++r) { const int at = 32 * ta + crow32(r, hf); const float G0a = GS[at], G1a = GS[64 + at], c = acc[r];
            if (!isqk) { if (at > bt) { Lt[bt * 64 + at] = beS[at] * c * fexp_(G0a - G0b); Lt[4096 + (63 - at) * 64 + (63 - bt)] = be1b * c * fexp_(G1b - G1a); } }
            else { if (ta >= tb) ((bf16*)(gt0 + GT_AT))[at * 64 + gperm(bt)] = (bf16)f2bf(at >= bt ? c * fexp_(G0a - G0b) : 0.f);
                   if (ta <= tb) ((bf16*)(gt1 + GT_AT))[(63 - at) * 64 + gperm(63 - bt)] = (bf16)f2bf(at <= bt ? c * fexp_(G1a - G1b) : 0.f); } }
    }
    BAR_LDS();
    if (wave < 2) {
        const int d = wave, c = lane; f32x2 xp[32];
        const LAS float* Lb = Lt + d * 4096; asm volatile("" : "+v"(Lb));
#pragma unroll
        for (int i = 0; i < 32; ++i) xp[i] = (f32x2){(2 * i == c) ? 1.f : 0.f, (2 * i + 1 == c) ? 1.f : 0.f};
        f32x4 LA[16], LB[16];
#define T_LOADCOL(buf, j) do { _Pragma("unroll") for (int i4 = ((j) + 1) / 4; i4 < 16; ++i4) buf[i4] = *(const LAS f32x4*)(Lb + (j) * 64 + 4 * i4); } while (0)
#define T_COMPCOL(buf, j) do { const float xj = xp[(j) >> 1][(j) & 1]; const f32x2 xj2 = {xj, xj}; _Pragma("unroll") for (int i4 = ((j) + 1) / 4; i4 < 16; ++i4) { const f32x4 l4 = buf[i4]; \
            if (4 * i4 > (j)) xp[2 * i4] -= (f32x2){l4.x, l4.y} * xj2; else if (4 * i4 + 1 > (j)) xp[2 * i4][1] -= l4.y * xj; \
            if (4 * i4 + 2 > (j)) xp[2 * i4 + 1] -= (f32x2){l4.z, l4.w} * xj2; else if (4 * i4 + 3 > (j)) xp[2 * i4 + 1][1] -= l4.w * xj; } } while (0)
        T_LOADCOL(LA, 0);
#pragma unroll
        for (int j = 0; j < 63; j += 2) {
            __builtin_amdgcn_sched_barrier(0);
            if (j + 1 < 63) T_LOADCOL(LB, j + 1);
            __builtin_amdgcn_sched_barrier(0);
            T_COMPCOL(LA, j);
            __builtin_amdgcn_sched_barrier(0);
            if (j + 2 < 63) T_LOADCOL(LA, j + 2);
            __builtin_amdgcn_sched_barrier(0);
            if (j + 1 < 63) T_COMPCOL(LB, j + 1);
        }
#undef T_LOADCOL
#undef T_COMPCOL
        const int ac = d ? 63 - c : c; const float bc = beS[d * 64 + ac], bec = bc * fexp_(GS[d * 64 + ac]);
        LAS unsigned char* tv = TVW + (d * 2) * 9216 + ac * 2; asm volatile("" : "+v"(tv));
#pragma unroll
        for (int i = 0; i < 64; ++i) { const float xi = xp[i >> 1][i & 1]; *(LAS bf16*)(tv + i * 144) = (bf16)f2bf(xi * bc); *(LAS bf16*)(tv + 9216 + i * 144) = (bf16)f2bf(xi * bec); }
    } else {
        for (int it = tid - 128; it < 2048; it += 384) { const int d = it >> 10, dd = (it >> 3) & 127, g8 = it & 7, grp = g8 >> 1, hp = g8 & 1; const float glast = d ? GS[64] : GS[63];
            unsigned w[4];
#pragma unroll
            for (int t = 0; t < 8; t += 2) { const int i0 = 16 * grp + 8 * (t >> 2) + 4 * hp + (t & 3), a0 = d ? 63 - i0 : i0, a1 = d ? a0 - 1 : a0 + 1;
                const float k0 = __builtin_bit_cast(float, (unsigned)(*(const LAS bf16*)(KTb + dd * 144 + a0 * 2)) << 16), k1 = __builtin_bit_cast(float, (unsigned)(*(const LAS bf16*)(KTb + dd * 144 + a1 * 2)) << 16);
                w[t >> 1] = pk2(k0 * fexp_(glast - GS[d * 64 + a0]), k1 * fexp_(glast - GS[d * 64 + a1])); }
            v4u o; o.x = w[0]; o.y = w[1]; o.z = w[2]; o.w = w[3];
            *(v4u*)((d ? gt1 : gt0) + GT_KT + (size_t)(dd * 64 + 16 * grp + 8 * hp) * 2) = o; }
    }
    BAR_LDS();
    { const int mi = wave >> 1, d = mi >> 1, isw = mi & 1, it = wave & 1;
      const LAS unsigned char* ap = TVW + (d * 2 + isw) * 9216 + (32 * it + c32) * 144 + hf * 16; const LAS unsigned char* bp = (isw ? KTb : VTb) + c32 * 144 + hf * 16;
      bf16x8 af[4];
#pragma unroll
      for (int s = 0; s < 4; ++s) af[s] = *(const LAS bf16x8*)(ap + 32 * s);
      unsigned char* go = d ? gt1 : gt0;
#pragma unroll
      for (int ct = 0; ct < 4; ++ct) { f32x16 acc;
#pragma unroll
          for (int r = 0; r < 16; ++r) acc[r] = 0.f;
          if (isw) {
#pragma unroll
              for (int s = 0; s < 4; ++s) acc = __builtin_amdgcn_mfma_f32_32x32x16_bf16(af[s], *(const LAS bf16x8*)(bp + ct * 32 * 144 + 32 * s), acc, 0, 0, 0);
              bf16* wp = (bf16*)(go + GT_NW) + gperm(32 * ct + c32);
#pragma unroll
              for (int r = 0; r < 16; ++r) wp[(32 * it + crow32(r, hf)) * 128] = (bf16)f2bf(-acc[r]);
          } else {
#pragma unroll
              for (int s = 0; s < 4; ++s) acc = __builtin_amdgcn_mfma_f32_32x32x16_bf16(*(const LAS bf16x8*)(bp + ct * 32 * 144 + 32 * s), af[s], acc, 0, 0, 0);
              bf16* up = (bf16*)(go + GT_UT) + gperm(32 * it + c32);
#pragma unroll
              for (int r = 0; r < 16; ++r) up[(32 * ct + crow32(r, hf)) * 64] = (bf16)f2bf(acc[r]); } } }
    BAR_LDS();
}
DI void lru_chunk_item(int item, const float* XC, const bf16* GWT, const float* gate_b, const float* lam, bf16* LA, bf16* LU, float* LCT, LAS unsigned char* lds, int tid) {
    const int rt = item >> 3, n = item & 7, rb = rt * 64;
    const int wave = __builtin_amdgcn_readfirstlane(tid >> 6), lane = tid & 63, c32 = lane & 31, hf = lane >> 5;
    LAS float* xs = (LAS float*)lds;
    LAS unsigned char* xb = lds + 64 * 65 * 4;
    LAS float* as_ = (LAS float*)(lds + 64 * 65 * 4 + 64 * 144);
    LAS float* us = as_ + 2 * 64 * 64;
#pragma unroll
    for (int e = 0; e < 2; ++e) { const int idx = tid + 512 * e, r = idx >> 4, c4 = (idx & 15) * 4; const f32x4 v = __builtin_nontemporal_load((const f32x4*)(XC + (size_t)(rb + r) * 512 + n * 64 + c4));
        xs[r * 65 + c4] = v.x; xs[r * 65 + c4 + 1] = v.y; xs[r * 65 + c4 + 2] = v.z; xs[r * 65 + c4 + 3] = v.w;
        v2u w; w.x = pk2(v.x, v.y); w.y = pk2(v.z, v.w); *(LAS v2u*)(xb + r * 144 + c4 * 2) = w; }
    BAR_LDS();
    { const int dir = wave >> 2, half = (wave >> 1) & 1, rtile = wave & 1, e = 32 * half + c32, ch = n * 64 + e;
      f32x16 acc0, acc1;
#pragma unroll
      for (int r = 0; r < 16; ++r) { acc0[r] = 0.f; acc1[r] = 0.f; }
      const bf16* b0p = GWT + ((size_t)((dir * 2 + 0) * 8 + n) * 64 + e) * 64 + 8 * hf; const bf16* b1p = GWT + ((size_t)((dir * 2 + 1) * 8 + n) * 64 + e) * 64 + 8 * hf;
      bf16x8 bw0[4], bw1[4];
#pragma unroll
      for (int s = 0; s < 4; ++s) { bw0[s] = *(const bf16x8*)(b0p + 16 * s); bw1[s] = *(const bf16x8*)(b1p + 16 * s); }
#pragma unroll
      for (int s = 0; s < 4; ++s) { const bf16x8 a = *(const LAS bf16x8*)(xb + (32 * rtile + c32) * 144 + (16 * s + 8 * hf) * 2);
          acc0 = __builtin_amdgcn_mfma_f32_32x32x16_bf16(a, bw0[s], acc0, 0, 0, 0);
          acc1 = __builtin_amdgcn_mfma_f32_32x32x16_bf16(a, bw1[s], acc1, 0, 0, 0); }
      const float gb0 = gate_b[(dir * 2 + 0) * 512 + ch], gb1 = gate_b[(dir * 2 + 1) * 512 + ch], spl = softplusf_(-lam[dir * 512 + ch]);
#pragma unroll
      for (int r = 0; r < 16; ++r) { const int row = 32 * rtile + crow32(r, hf); const float xv = xs[row * 65 + e];
          const float rgt = sigmoidf_(acc0[r] + gb0), igt = sigmoidf_(acc1[r] + gb1); const float a = fexp_(-8.0f * rgt * spl);
          as_[(dir * 64 + row) * 64 + e] = a; us[(dir * 64 + row) * 64 + e] = sqrtf(fmaxf(1.0f - a * a, 0.f)) * (igt * xv); } }
    BAR_LDS();
    if (wave < 2) { const int dir = wave, e = lane, ch = n * 64 + e; float hl = 0.f, cp = 1.f;
        const LAS float* ap = as_ + dir * 4096 + e; const LAS float* up = us + dir * 4096 + e; const size_t ob = ((size_t)dir * MT + rb) * 512 + ch;
#pragma unroll 16
        for (int i = 0; i < 64; ++i) { const int r = dir ? 63 - i : i; const float a = ap[r * 64], u = up[r * 64]; hl = a * hl + u; cp *= a; __builtin_nontemporal_store((bf16)f2bf(hl), LU + ob + (size_t)r * 512); __builtin_nontemporal_store((bf16)f2bf(cp), LA + ob + (size_t)r * 512); }
        float* ct = LCT + (((size_t)dir * NCHUNK + rt) * 512 + ch) * 2; ct[0] = cp; ct[1] = hl; }
    BAR_LDS();
}
template <bool ALLOW_FIXED>
DI void ph_attention(const bf16* QB, const bf16* KB, const bf16* VB, bf16* Y, int u0, int nunits, char* lds, int ustride, const float* qg, const float* kg) {
    bool fixed = false;
    if constexpr (ALLOW_FIXED) { int t_ = threadIdx.x; asm volatile("" : "+v"(t_)); const int lane = t_ & 63;
        float mq = fmaxf(fabsf(qg[lane]), fabsf(qg[64 + lane])), mk = fmaxf(fabsf(kg[lane]), fabsf(kg[64 + lane]));
#pragma unroll
        for (int o = 1; o < 64; o <<= 1) { mq = fmaxf(mq, __shfl_xor(mq, o)); mk = fmaxf(mk, __shfl_xor(mk, o)); }
        const float B = 11.313708499f * 1.02f * mq * mk;
        fixed = __builtin_amdgcn_readfirstlane((int)(B <= 40.f)) != 0; }
    for (int u = u0; u < nunits; u += ustride) {
        size_t qrow, kvrow; int hq, kvh, seq;
        if (u < 512) { const int grp = u & 7, idx = u >> 3, b = grp >> 1; kvh = grp & 1; hq = kvh * 4 + (idx >> 4); qrow = (size_t)b * SEQ + (idx & 15) * 256; kvrow = (size_t)b * SKV; seq = SKV; }
        else { const int v = u - 512, b = v >> 3; hq = v & 7; kvh = hq >> 2; qrow = (size_t)ML + b * CTXL; kvrow = (size_t)b * SKV + SEQ; seq = CTXL; }
        __syncthreads();
        if (ALLOW_FIXED && fixed) att::attn_dense_body<att::bf16, true>((const att::bf16*)(QB + qrow * 1024 + hq * 128), (const att::bf16*)(KB + kvrow * 256 + kvh * 128), (const att::bf16*)(VB + kvrow * 256 + kvh * 128), Y + qrow * DM + 512 + hq * 128, seq, lds);
        else att::attn_dense_body<att::bf16, false>((const att::bf16*)(QB + qrow * 1024 + hq * 128), (const att::bf16*)(KB + kvrow * 256 + kvh * 128), (const att::bf16*)(VB + kvrow * 256 + kvh * 128), Y + qrow * DM + 512 + hq * 128, seq, lds);
    }
}
DI void ph_lru_carry(const float* LCT, float* LCI, int bid, int tid) {
    const int gid = bid * 512 + tid; if (gid >= 4096) return;
    const int b = gid >> 10, dir = (gid >> 9) & 1, ch = gid & 511; float c = 0.f;
    for (int k0 = 0; k0 < 68; k0 += 34) {
        f32x2 t[34]; int kk = k0; asm volatile("" : "+v"(kk));
#pragma unroll
        for (int k = 0; k < 34; ++k) { const int sc = chain_chunk(b, dir, kk + k); t[k] = *(const f32x2*)(LCT + (((size_t)dir * NCHUNK + sc) * 512 + ch) * 2); }
#pragma unroll
        for (int k = 0; k < 34; ++k) { const int sc = chain_chunk(b, dir, kk + k); LCI[((size_t)dir * NCHUNK + sc) * 512 + ch] = c; c = t[k].x * c + t[k].y; }
    }
}
constexpr int SC_NW = 0, SC_QD = 17408, SC_KT = 34816, SC_AT = 53248, SC_UT = 62464, SC_DEC = 80896, SC_BUF = 80960;
static_assert(2 * SC_BUF <= PH_LDS, "scan LDS");
struct ScanRegs { v4u p[18]; float dec; };
DI void scan_issue(ScanRegs& R, const unsigned char* gt, const float* decp, int lt) {
    asm volatile("" : "+v"(lt));
#pragma unroll
    for (int e = 0; e < 18; ++e) R.p[e] = __builtin_nontemporal_load((const v4u*)(gt + (size_t)(lt + 256 * e) * 16));
    R.dec = *decp;
}
DI void scan_write(const ScanRegs& R, LAS unsigned char* buf, int lt) {
    asm volatile("" : "+v"(lt));
#pragma unroll
    for (int e = 0; e < 18; ++e) { const int p = lt + 256 * e;
        int off; if (e < 8) { const int q = p & 1023; off = (e < 4 ? SC_NW : SC_QD) + (q >> 4) * 272 + (q & 15) * 16; }
        else if (e < 12) { const int q = p - 2048; off = SC_KT + (q >> 3) * 144 + (q & 7) * 16; }
        else if (e < 14) { const int q = p - 3072; off = SC_AT + (q >> 3) * 144 + (q & 7) * 16; }
        else { const int q = p - 3584; off = SC_UT + (q >> 3) * 144 + (q & 7) * 16; }
        *(LAS v4u*)(buf + off) = R.p[e]; }
    if (lt == 0) *(LAS float*)(buf + SC_DEC) = R.dec;
}
template <int D> DI void gdn_scan_chain_d(int chain, const unsigned char* GT, const float* GG, bf16* OF, bf16* OB, LAS unsigned char* lds, int tid) {
    const int b = chain >> 3, hd = (chain >> 1) & 3; constexpr int d = D;
    const int wave = __builtin_amdgcn_readfirstlane(tid >> 6), lane = tid & 63, c32 = lane & 31, hf = lane >> 5;
    bf16* Od = d ? OB : OF;
#define SCAN_BAR() do { asm volatile("s_waitcnt lgkmcnt(0)" ::: "memory"); __builtin_amdgcn_s_barrier(); asm volatile("" ::: "memory"); } while (0)
#define TASK_OF(k) ((size_t)((chain_chunk(b, d, (k)) * 4 + hd) * 2 + d))
    if (wave >= 4) {
        const int lt = tid - 256; ScanRegs R0, R1;
        scan_issue(R0, GT + TASK_OF(0) * GT_BYTES, GG + TASK_OF(0), lt); scan_issue(R1, GT + TASK_OF(1) * GT_BYTES, GG + TASK_OF(1), lt);
        scan_write(R0, lds, lt); scan_issue(R0, GT + TASK_OF(2) * GT_BYTES, GG + TASK_OF(2), lt);
        SCAN_BAR();
        for (int k = 0; k < 68; k += 2) {
            scan_write(R1, lds + SC_BUF, lt); if (k + 3 < 68) scan_issue(R1, GT + TASK_OF(k + 3) * GT_BYTES, GG + TASK_OF(k + 3), lt);
            SCAN_BAR();
            if (k + 2 < 68) scan_write(R0, lds, lt); if (k + 4 < 68) scan_issue(R0, GT + TASK_OF(k + 4) * GT_BYTES, GG + TASK_OF(k + 4), lt);
            SCAN_BAR();
        }
    } else {
        const int ws = wave; f32x16 S[4], vacc[2];
#pragma unroll
        for (int t = 0; t < 4; ++t)
#pragma unroll
            for (int r = 0; r < 16; ++r) S[t][r] = 0.f;
        bf16x8 If[2];
#pragma unroll
        for (int s = 0; s < 2; ++s)
#pragma unroll
            for (int j = 0; j < 8; ++j) If[s][j] = (c32 == 16 * s + 8 * (j >> 2) + 4 * hf + (j & 3)) ? (short)0x3F80 : (short)0;
        SCAN_BAR();
        const int aoff = c32 * 272 + hf * 16, koff = c32 * 144 + hf * 16;
#define SB() __builtin_amdgcn_sched_barrier(0)
#define LD_ROW(F, base, it_, tp_) do { _Pragma("unroll") for (int i_ = 0; i_ < 4; ++i_) F[i_] = *(const LAS bf16x8*)(buf + (base) + aoff + (it_) * 32 * 272 + (32 * (2 * (tp_) + (i_ >> 1)) + 16 * (i_ & 1)) * 2); } while (0)
#define MM_ROW(F, acc, tp_) do { _Pragma("unroll") for (int i_ = 0; i_ < 4; ++i_) acc = __builtin_amdgcn_mfma_f32_32x32x16_bf16(F[i_], Sp[2 * (tp_) + (i_ >> 1)][i_ & 1], acc, 0, 0, 0); } while (0)
#define LD_AT(F, it_, n_) do { _Pragma("unroll") for (int i_ = 0; i_ < (n_); ++i_) F[i_] = *(const LAS bf16x8*)(buf + SC_AT + koff + (it_) * 32 * 144 + (32 * (i_ >> 1) + 16 * (i_ & 1)) * 2); } while (0)
#define MM_AT(F, acc, n_) do { _Pragma("unroll") for (int i_ = 0; i_ < (n_); ++i_) acc = __builtin_amdgcn_mfma_f32_32x32x16_bf16(F[i_], vp[i_ >> 1][i_ & 1], acc, 0, 0, 0); } while (0)
#define LD_KT(F, t_) do { _Pragma("unroll") for (int i_ = 0; i_ < 4; ++i_) F[i_] = *(const LAS bf16x8*)(buf + SC_KT + koff + (t_) * 32 * 144 + (32 * (i_ >> 1) + 16 * (i_ & 1)) * 2); } while (0)
#define MM_KT(F, t_) do { _Pragma("unroll") for (int i_ = 0; i_ < 4; ++i_) S[t_] = __builtin_amdgcn_mfma_f32_32x32x16_bf16(F[i_], vp[i_ >> 1][i_ & 1], S[t_], 0, 0, 0); } while (0)
#define ST_O(o, it_) do { const int i0 = 32 * (it_) + 4 * hfo; bf16* ob = Od + ((size_t)sc * 64 + (d ? 63 - i0 : i0)) * 512 + hd * 128 + 32 * ws + c32; \
        _Pragma("unroll") for (int r = 0; r < 16; r += 2) { const unsigned w2 = pk2(o[r], o[r + 1]); const int dr = (r & 3) + 8 * (r >> 2); \
            __builtin_nontemporal_store((bf16)w2, ob + (d ? -dr : dr) * 512); __builtin_nontemporal_store((bf16)(w2 >> 16), ob + (d ? -(dr + 1) : dr + 1) * 512); } } while (0)
        for (int k = 0; k < 68; ++k) {
            const LAS unsigned char* buf = lds + (k & 1) * SC_BUF; const int sc = chain_chunk(b, d, k); const size_t tk = (size_t)((sc * 4 + hd) * 2 + d);
            const float dec = *(const LAS float*)(buf + SC_DEC);
            int hfo = hf; asm volatile("" : "+v"(hfo));
            bf16x8 Sp[4][2], vp[2][2], F0[4], F1[4]; f32x16 o;
#pragma unroll
            for (int t = 0; t < 4; ++t) { Sp[t][0] = pack_acc(S[t], 0); Sp[t][1] = pack_acc(S[t], 1); }
            { const LAS unsigned char* up = buf + SC_UT + (32 * ws + c32) * 144 + hf * 16;
#pragma unroll
              for (int i_ = 0; i_ < 4; ++i_) F1[i_] = *(const LAS bf16x8*)(up + (32 * (i_ >> 1) + 16 * (i_ & 1)) * 2); }
            LD_ROW(F0, SC_NW, 0, 0); SB();
#pragma unroll
            for (int it = 0; it < 2; ++it) {
#pragma unroll
                for (int r = 0; r < 16; ++r) vacc[it][r] = 0.f;
                vacc[it] = __builtin_amdgcn_mfma_f32_32x32x16_bf16(If[0], F1[2 * it], vacc[it], 0, 0, 0); vacc[it] = __builtin_amdgcn_mfma_f32_32x32x16_bf16(If[1], F1[2 * it + 1], vacc[it], 0, 0, 0); }
            SB();
            LD_ROW(F1, SC_NW, 0, 1); SB(); MM_ROW(F0, vacc[0], 0); SB();
            LD_ROW(F0, SC_NW, 1, 0); SB(); MM_ROW(F1, vacc[0], 1); SB();
            LD_ROW(F1, SC_NW, 1, 1); SB(); MM_ROW(F0, vacc[1], 0); SB();
            LD_ROW(F0, SC_QD, 0, 0); SB(); MM_ROW(F1, vacc[1], 1); SB();
            vp[0][0] = pack_acc(vacc[0], 0); vp[0][1] = pack_acc(vacc[0], 1); vp[1][0] = pack_acc(vacc[1], 0); vp[1][1] = pack_acc(vacc[1], 1); SB();
#pragma unroll
            for (int r = 0; r < 16; ++r) o[r] = 0.f;
            LD_ROW(F1, SC_QD, 0, 1); SB(); MM_ROW(F0, o, 0); SB();
            LD_AT(F0, 0, 2); SB(); MM_ROW(F1, o, 1); SB();
            LD_ROW(F1, SC_QD, 1, 0); SB(); MM_AT(F0, o, 2); SB();
            ST_O(o, 0); SB();
#pragma unroll
            for (int r = 0; r < 16; ++r) o[r] = 0.f;
            LD_ROW(F0, SC_QD, 1, 1); SB(); MM_ROW(F1, o, 0); SB();
            LD_AT(F1, 1, 4); SB(); MM_ROW(F0, o, 1); SB();
            LD_KT(F0, 0); SB(); MM_AT(F1, o, 4); SB();
            ST_O(o, 1); SB();
#pragma unroll
            for (int t = 0; t < 4; ++t) S[t] = S[t] * dec;
            LD_KT(F1, 1); SB(); MM_KT(F0, 0); SB();
            LD_KT(F0, 2); SB(); MM_KT(F1, 1); SB();
            LD_KT(F1, 3); SB(); MM_KT(F0, 2); SB();
            MM_KT(F1, 3); SB();
            SCAN_BAR();
        }
#undef SB
#undef LD_ROW
#undef MM_ROW
#undef LD_AT
#undef MM_AT
#undef LD_KT
#undef MM_KT
#undef ST_O
    }
#undef TASK_OF
#undef SCAN_BAR
}
DI void gdn_scan_chain(int chain, const unsigned char* GT, const float* GG, bf16* OF, bf16* OB, LAS unsigned char* lds, int tid) {
    if (chain & 1) gdn_scan_chain_d<1>(chain, GT, GG, OF, OB, lds, tid); else gdn_scan_chain_d<0>(chain, GT, GG, OF, OB, lds, tid);
}
struct PostLd { v4u of, ob, z, hf, af, hb, ab, gt; f32x4 cf0, cf1, cb0, cb1; };
DI void post_issue(PostLd& L, int m, const bf16* P, const bf16* OF, const bf16* OB, const bf16* LA, const bf16* LU, const float* LCI, int col) {
    const int sc = m >> 6; const size_t o0 = (size_t)m * 512 + col, o1 = ((size_t)MT + m) * 512 + col;
    L.of = __builtin_nontemporal_load((const v4u*)(OF + o0)); L.ob = __builtin_nontemporal_load((const v4u*)(OB + o0)); L.z = *(const v4u*)(P + (size_t)m * NINP + PC_Z + col);
    L.hf = __builtin_nontemporal_load((const v4u*)(LU + o0)); L.af = __builtin_nontemporal_load((const v4u*)(LA + o0)); L.hb = __builtin_nontemporal_load((const v4u*)(LU + o1)); L.ab = __builtin_nontemporal_load((const v4u*)(LA + o1));
    L.gt = *(const v4u*)(P + (size_t)m * NINP + PC_LG + col);
    L.cf0 = *(const f32x4*)(LCI + (size_t)sc * 512 + col); L.cf1 = *(const f32x4*)(LCI + (size_t)sc * 512 + col + 4); L.cb0 = *(const f32x4*)(LCI + ((size_t)NCHUNK + sc) * 512 + col); L.cb1 = *(const f32x4*)(LCI + ((size_t)NCHUNK + sc) * 512 + col + 4);
    asm volatile("" ::: "memory");
}
DI void post_finish(const PostLd& L, int m, const f32x4 g0, const f32x4 g1, bf16* Y, int col) {
    { float of[8], ob[8], o[8], z[8]; float ss = 0.f;
      unpack8(L.of, of); unpack8(L.ob, ob); unpack8(L.z, z);
#pragma unroll
      for (int e = 0; e < 8; ++e) { o[e] = of[e] + ob[e]; ss += o[e] * o[e]; }
      ss += __shfl_xor(ss, 1); ss += __shfl_xor(ss, 2); ss += __shfl_xor(ss, 4); ss += __shfl_xor(ss, 8);
      const float rstd = 1.0f / sqrtf(ss * (1.0f / 128.0f) + EPS);
      const float g[8] = {g0.x, g0.y, g0.z, g0.w, g1.x, g1.y, g1.z, g1.w}; float y[8];
#pragma unroll
      for (int e = 0; e < 8; ++e) y[e] = o[e] * rstd * g[e] * siluf_(z[e]);
      v4u w; w.x = pk2(y[0], y[1]); w.y = pk2(y[2], y[3]); w.z = pk2(y[4], y[5]); w.w = pk2(y[6], y[7]);
      *(v4u*)(Y + (size_t)m * DM + col) = w; }
    { float hf[8], af[8], hb[8], ab[8], gt[8], y[8];
      unpack8(L.hf, hf); unpack8(L.af, af); unpack8(L.hb, hb); unpack8(L.ab, ab); unpack8(L.gt, gt);
      const float cf[8] = {L.cf0.x, L.cf0.y, L.cf0.z, L.cf0.w, L.cf1.x, L.cf1.y, L.cf1.z, L.cf1.w}, cb[8] = {L.cb0.x, L.cb0.y, L.cb0.z, L.cb0.w, L.cb1.x, L.cb1.y, L.cb1.z, L.cb1.w};
#pragma unroll
      for (int e = 0; e < 8; ++e) y[e] = gelu_tanhf_(gt[e]) * ((hf[e] + af[e] * cf[e]) + (hb[e] + ab[e] * cb[e]));
      v4u w; w.x = pk2(y[0], y[1]); w.y = pk2(y[2], y[3]); w.z = pk2(y[4], y[5]); w.w = pk2(y[6], y[7]);
      *(v4u*)(Y + (size_t)m * DM + 1536 + col) = w; }
}
DI void ph_post(const bf16* P, const bf16* OF, const bf16* OB, const float* gn, const bf16* LA, const bf16* LU, const float* LCI, bf16* Y, int Mrows, int gw, int ngw, int lane) {
    const int col = 8 * lane;
    const f32x4 g0 = *(const f32x4*)(gn + (col & 127)), g1 = *(const f32x4*)(gn + (col & 127) + 4);
    PostLd A, B; int m = gw;
    if (m < Mrows) post_issue(A, m, P, OF, OB, LA, LU, LCI, col);
    for (; m < Mrows; m += 2 * ngw) { const int m2 = m + ngw, m3 = m2 + ngw;
        if (m2 < Mrows) post_issue(B, m2, P, OF, OB, LA, LU, LCI, col);
        post_finish(A, m, g0, g1, Y, col);
        if (m3 < Mrows) post_issue(A, m3, P, OF, OB, LA, LU, LCI, col);
        if (m2 < Mrows) post_finish(B, m2, g0, g1, Y, col);
    }
}
DI void ph_convfix(const float* RAW, const float* cw, const float* cb, bf16* A, int npanels, int bid, int G, int tid) {
    const int total = npanels * 2 * (FF / 8);
    for (int idx = bid * 512 + tid; idx < total; idx += G * 512) {
        const int pe = idx / (FF / 8), j = (idx - pe * (FF / 8)) * 8, pm = pe >> 1, bot = pe & 1, row = pm * 256 + (bot ? 255 : 0); const RowInfo ri = row_info(row);
        const float* rc = RAW + ((size_t)pm * 4 + (bot ? 3 : 0)) * FF2 + j;
        const float* rp = bot ? rc - FF2 : rc - FF2;
        const float* rn = bot ? rc + FF2 : rc + FF2;
        const bool hp = ri.t > 0, hn = ri.t + 1 < ri.T;
        float r[2][8];
#pragma unroll
        for (int half = 0; half < 2; ++half) { const int o = half * FF;
            f32x4 a0 = *(const f32x4*)(cb + o + j), a1 = *(const f32x4*)(cb + o + j + 4);
#pragma unroll
            for (int tap = 0; tap < 3; ++tap) { const float* src = tap == 0 ? rp : (tap == 1 ? rc : rn); const bool ok = tap == 0 ? hp : (tap == 1 ? true : hn);
                if (ok) { a0 += *(const f32x4*)(cw + tap * FF2 + o + j) * *(const f32x4*)(src + o); a1 += *(const f32x4*)(cw + tap * FF2 + o + j + 4) * *(const f32x4*)(src + o + 4); } }
            r[half][0] = a0.x; r[half][1] = a0.y; r[half][2] = a0.z; r[half][3] = a0.w; r[half][4] = a1.x; r[half][5] = a1.y; r[half][6] = a1.z; r[half][7] = a1.w; }
        v4u w; w.x = pk2(siluf_(r[0][0]) * r[1][0], siluf_(r[0][1]) * r[1][1]); w.y = pk2(siluf_(r[0][2]) * r[1][2], siluf_(r[0][3]) * r[1][3]);
        w.z = pk2(siluf_(r[0][4]) * r[1][4], siluf_(r[0][5]) * r[1][5]); w.w = pk2(siluf_(r[0][6]) * r[1][6], siluf_(r[0][7]) * r[1][7]);
        *(v4u*)(A + (size_t)row * FF + j) = w;
    }
}
DI void ph_final_norm(const bf16* X, const float* g, float* out, int gw, int ngw, int lane) {
    for (int m = gw; m < ML; m += ngw) {
        const v4u* xr = (const v4u*)(X + (size_t)m * DM) + lane; v4u xb[4]; f32x4 v[8]; float ss = 0.f;
#pragma unroll
        for (int j = 0; j < 4; ++j) xb[j] = xr[64 * j];
#pragma unroll
        for (int j = 0; j < 4; ++j) { v[2 * j] = (f32x4){bf_lo(xb[j].x), bf_hi(xb[j].x), bf_lo(xb[j].y), bf_hi(xb[j].y)}; v[2 * j + 1] = (f32x4){bf_lo(xb[j].z), bf_hi(xb[j].z), bf_lo(xb[j].w), bf_hi(xb[j].w)}; }
#pragma unroll
        for (int j = 0; j < 8; ++j) ss += (v[j].x * v[j].x + v[j].y * v[j].y) + (v[j].z * v[j].z + v[j].w * v[j].w);
        const float rstd = 1.0f / sqrtf(wave_sum(ss) * (1.0f / DM) + EPS);
        f32x4* orow = (f32x4*)(out + (size_t)m * DM) + 2 * lane;
        f32x4 gg[8];
#pragma unroll
        for (int j = 0; j < 8; ++j) gg[j] = *(const f32x4*)(g + 512 * (j >> 1) + 8 * lane + 4 * (j & 1));
#pragma unroll
        for (int j = 0; j < 8; ++j) orow[128 * (j >> 1) + (j & 1)] = v[j] * rstd * gg[j];
    }
}

#ifndef MK_ONE_LAUNCH
#define MK_ONE_LAUNCH 1
#endif
#ifndef TESTSEL
#define TESTSEL 0
#endif
#ifndef PH_MASK
#define PH_MASK 0xFFFFFFFFu
#endif
#define PHEN(j) (((PH_MASK) >> (j)) & 1u)
#ifndef DUP_PH
#define DUP_PH -1
#endif
#ifndef DUP_SUB
#define DUP_SUB 0
#endif
#define REP(j) for (int rep_ = 0; rep_ < ((DUP_PH) == (j) ? 2 : 1); ++rep_)
constexpr int NPH = 2 + 12 * DEPTH + 1;
struct Args { const float* in[26]; float* out; unsigned char* ws; int ph_lo, ph_hi; };
typedef __attribute__((address_space(4))) Args KArgs;
__global__ void __launch_bounds__(512, 2) fwd_kernel(Args args) {
    extern __shared__ __attribute__((aligned(16))) unsigned char lds_raw[];
    LAS unsigned char* lds = (LAS unsigned char*)lds_raw;
    volatile LAS unsigned* MISC = (volatile LAS unsigned*)(lds + MISC_OFF);
    const int G0 = gridDim.x, bid = blockIdx.x;
    const int lo = args.ph_lo, hi = args.ph_hi;
    for (int u = threadIdx.x; u < 64; u += 512) MISC[u] = 0u;
    __syncthreads();
    XcdBarrier bar;
    { unsigned* bw = (unsigned*)(args.ws + WS_CTL) + CW_BAR; bar.bar = bw; bar.x = 0; bar.st = nullptr; if (hi - lo > 1) bar = xcd_barrier_post(bw, MISC + 8); }
#define IN(k) (lo <= (k) && (k) < hi)
#ifndef DUP_BAR
#define DUP_BAR 0
#endif
#define SEAM(k) do { if (IN(k) && IN((k) + 1)) { xcd_barrier(bar); if (DUP_BAR) xcd_barrier(bar); } } while (0)
#define WSL() int tid = threadIdx.x; asm volatile("" : "+v"(tid)); int G = G0; asm volatile("" : "+s"(G)); const int ngw = G * 8; (void)ngw; const int lane = tid & 63, wave = __builtin_amdgcn_readfirstlane(tid >> 6), gw = bid * 8 + wave; (void)lane; (void)gw; GAS unsigned char* ws = (GAS unsigned char*)args.ws; asm volatile("" : "+s"(ws)); const KArgs* ka = (const KArgs*)__builtin_amdgcn_kernarg_segment_ptr(); asm volatile("" : "+s"(ka))
#define INP(k) ((const float*)((const GAS float*)ka->in[k]))
#define W_(type, off) ((type*)((GAS type*)(ws + (off))))

    if (PHEN(0) && IN(0)) { WSL(); ph_prologue_a(INP(0), INP(2), INP(1), INP(3), INP(4), W_(bf16, WS_X), W_(float, WS_ROPE), W_(float, WS_MODP), lds, bid, G, tid);
        __syncthreads(); ph_wconv(INP(8), INP(20), INP(21), INP(24), INP(17), W_(bf16, WS_WIN), W_(bf16, WS_WOUT), W_(bf16, WS_WUP), W_(bf16, WS_WDN), W_(bf16, WS_GWT), lds, gw, ngw, wave, lane); SEAM(0); }
    if (PHEN(1) && IN(1)) { WSL(); ph_prologue_b(INP(5), W_(float, WS_MODP), W_(float, WS_MOD), bid, G, tid); SEAM(1); }
    for (int L = 0; L < DEPTH; ++L) {
        const int pb = 2 + 12 * L;
        if (pb + 12 <= lo || pb >= hi) continue;
        const bool ctx_out = L < DEPTH - 1; const int Mrows = ctx_out ? MT : ML;
        const size_t wset = (L & 1) ? (WS_WSET1 - WS_WIN) : 0;
        if (PHEN(2) && IN(pb + 0)) { REP(2) { WSL();
            ph_norm_mod(W_(bf16, WS_X), INP(6) + L * DM, W_(float, WS_MOD) + (size_t)L * 5 * NMODV, 0, DM, W_(bf16, WS_H), MT, (L > 0 && G == 256) ? W_(bf16, WS_SLAB) : nullptr, gw, ngw, lane);
            }
            SEAM(pb + 0); }
        if (PHEN(3) && IN(pb + 1)) { REP(3) { WSL();
            pg8::Gemm g{W_(bf16, WS_H), W_(bf16, WS_WIN + wset), MT, 4608, DM}; pg8::StaticOrder S; S.init(MT, 4608, G, bid, DM); pg8::EpiStoreBf16 E{W_(bf16, WS_P), NINP};
            pg8::gemm_phase<pg8::EpiStoreBf16, pg8::StaticOrder, false, true>(lds, g, S, E);
            ph_small_cols(W_(bf16, WS_H), W_(bf16, WS_WIN + wset), W_(float, WS_PS), gw, ngw, lane);
            }
            SEAM(pb + 1); }
        if (PHEN(4) && IN(pb + 2)) { REP(4) { WSL();
            ph_tokprep(W_(bf16, WS_P), W_(float, WS_PS), INP(9) + (size_t)L * 4 * 1536, INP(10) + L * 8, INP(11) + L * 8, INP(13) + L * 128, INP(14) + L * 128, W_(float, WS_ROPE),
                       INP(15) + (size_t)L * 4 * 512, INP(16) + L * 512, W_(bf16, WS_QKVC), W_(float, WS_LAB), W_(bf16, WS_QB), W_(bf16, WS_KB), W_(bf16, WS_VB), W_(float, WS_XC), gw, ngw, lane);
            }
            SEAM(pb + 2); }
        if (PHEN(5) && IN(pb + 3)) { REP(5) { WSL();
            if (TESTSEL != 2 && !(rep_ == 1 && DUP_SUB == 2)) { GdnRegs GR;
                for (int it = bid; it < NGTASK / 2; it += G) { int t2 = tid; asm volatile("" : "+v"(t2));
                    gdn_chunk_task(it, it + G < NGTASK / 2 ? it + G : -1, GR, W_(bf16, WS_QKVC), W_(float, WS_LAB), W_(unsigned char, WS_GT), W_(float, WS_GG), lds, t2); } }
            const bool bal = (G == 256); const int li0 = bal ? (bid >= 64 ? bid - 64 : NGTASK) : bid, lis = bal ? 192 : G, lie = bal ? 576 : NGTASK;
            if (TESTSEL != 1 && !(rep_ == 1 && DUP_SUB == 1)) for (int it = li0; it < lie; it += lis) { int t2 = tid; asm volatile("" : "+v"(t2));
                lru_chunk_item(it, W_(float, WS_XC), W_(bf16, WS_GWT + wset), INP(18) + L * 2 * 2 * 512, INP(19) + L * 2 * 512, W_(bf16, WS_LA), W_(bf16, WS_LU), W_(float, WS_LCT), lds, t2); }
            }
            SEAM(pb + 3); }
        if (PHEN(7) && IN(pb + 4)) { REP(7) { WSL();
            if (bid < 32) { if (!(rep_ == 1 && DUP_SUB == 2)) { __syncthreads(); gdn_scan_chain(bid, W_(unsigned char, WS_GT), W_(float, WS_GG), W_(bf16, WS_OF), W_(bf16, WS_OB), lds, tid); } }
            else if (bid >= 40 && !(rep_ == 1 && DUP_SUB == 1)) {
                if (G == 256) for (int it = 576 + bid - 40; it < NGTASK; it += 216) { int t2 = tid; asm volatile("" : "+v"(t2));
                    lru_chunk_item(it, W_(float, WS_XC), W_(bf16, WS_GWT + wset), INP(18) + L * 2 * 2 * 512, INP(19) + L * 2 * 512, W_(bf16, WS_LA), W_(bf16, WS_LU), W_(float, WS_LCT), lds, t2); }
                if (G == 256 && ctx_out && rep_ == 0) { __syncthreads();
                    ph_attention<false>(W_(bf16, WS_QB), W_(bf16, WS_KB), W_(bf16, WS_VB), W_(bf16, WS_Y), 512 + (bid - 40), 544, (char*)lds_raw, 216, nullptr, nullptr); }
                if (L + 1 < DEPTH) { const size_t wn = ((L + 1) & 1) ? (WS_WSET1 - WS_WIN) : 0;
                    __syncthreads();
                    ph_wconv(INP(8) + (size_t)(L + 1) * DM * 4624, INP(20) + (size_t)(L + 1) * DM * DM, INP(21) + (size_t)(L + 1) * DM * FF2, INP(24) + (size_t)(L + 1) * FF * DM, INP(17) + (size_t)(L + 1) * 2 * 2 * 8 * 4096,
                             W_(bf16, WS_WIN + wn), W_(bf16, WS_WOUT + wn), W_(bf16, WS_WUP + wn), W_(bf16, WS_WDN + wn), W_(bf16, WS_GWT + wn), lds, (bid - 40) * 8 + wave, (G - 40) * 8, wave, lane); } }
            }
            SEAM(pb + 4); }
        if (PHEN(6) && IN(pb + 5)) { REP(6) { WSL();
            if (bid >= G - 8 && rep_ == 0) ph_lru_carry(W_(float, WS_LCT), W_(float, WS_LCI), bid - (G - 8), tid);
            ph_attention<true>(W_(bf16, WS_QB), W_(bf16, WS_KB), W_(bf16, WS_VB), W_(bf16, WS_Y), bid, (ctx_out && G != 256) ? 544 : 512, (char*)lds_raw, G, INP(13) + L * 128, INP(14) + L * 128);
            }
            SEAM(pb + 5); }
        if (PHEN(8) && IN(pb + 6)) { REP(8) { WSL();
            ph_post(W_(bf16, WS_P), W_(bf16, WS_OF), W_(bf16, WS_OB), INP(12) + L * 128, W_(bf16, WS_LA), W_(bf16, WS_LU), W_(float, WS_LCI), W_(bf16, WS_Y), Mrows, gw, ngw, lane);
            }
            SEAM(pb + 6); }
        if (PHEN(9) && IN(pb + 7)) { REP(9) { WSL();
            pg8::Gemm g{W_(bf16, WS_Y), W_(bf16, WS_WOUT + wset), Mrows, DM, DM}; pg8::TailSplitOrder S; S.init(Mrows, DM, G, bid, DM); pg8::EpiResGate E{rep_ ? W_(bf16, WS_BIG + 160 * MiB + 2 * MiB) : W_(bf16, WS_X), DM, W_(float, WS_MOD) + (size_t)L * 5 * NMODV + 2 * DM, NMODV, W_(bf16, WS_SLAB)};
            pg8::gemm_phase<pg8::EpiResGate, pg8::TailSplitOrder, true, true>(lds, g, S, E);
            }
            SEAM(pb + 7); }
        if (PHEN(10) && IN(pb + 8)) { REP(10) { WSL();
            ph_norm_mod(W_(bf16, WS_X), INP(7) + L * DM, W_(float, WS_MOD) + (size_t)L * 5 * NMODV, 3 * DM, 4 * DM, W_(bf16, WS_H), Mrows, (ctx_out && G == 256) ? W_(bf16, WS_SLAB) : nullptr, gw, ngw, lane);
            }
            SEAM(pb + 8); }
        if (PHEN(11) && IN(pb + 9)) { REP(11) { WSL();
            pg8::Gemm g{W_(bf16, WS_H), W_(bf16, WS_WUP + wset), Mrows, FF2, DM}; pg8::StaticOrder S; S.init(Mrows, FF2, G, bid, DM);
            pg8::EpiConvGlu E{W_(bf16, WS_A), FF, INP(22) + (size_t)L * 3 * FF2, INP(23) + (size_t)L * FF2, W_(float, WS_U), lds + 131072};
            pg8::gemm_phase<pg8::EpiConvGlu, pg8::StaticOrder, true, true>(lds, g, S, E);
            }
            SEAM(pb + 9); }
        if (PHEN(12) && IN(pb + 10)) { REP(12) { WSL();
            ph_convfix(W_(float, WS_U), INP(22) + (size_t)L * 3 * FF2, INP(23) + (size_t)L * FF2, W_(bf16, WS_A), Mrows / 256, bid, G, tid);
            }
            SEAM(pb + 10); }
        if (PHEN(13) && IN(pb + 11)) { REP(13) { WSL();
            pg8::Gemm g{W_(bf16, WS_A), W_(bf16, WS_WDN + wset), Mrows, DM, FF}; pg8::TailSplitOrder S; S.init(Mrows, DM, G, bid, FF); pg8::EpiResGate E{rep_ ? W_(bf16, WS_BIG + 560 * MiB) : W_(bf16, WS_X), DM, W_(float, WS_MOD) + (size_t)L * 5 * NMODV + 5 * DM, NMODV, W_(bf16, WS_SLAB)};
            pg8::gemm_phase<pg8::EpiResGate, pg8::TailSplitOrder, true, true>(lds, g, S, E);
            }
            SEAM(pb + 11); }
    }
    if (PHEN(14) && IN(NPH - 1)) { WSL(); ph_final_norm(W_(bf16, WS_X), INP(25), (float*)((GAS float*)ka->out), gw, ngw, lane); }
#undef IN
#undef SEAM
#undef WSL
#undef INP
#undef W_
}

extern "C" void kernel_launch(void* const* d_in, const int* in_sizes, int n_in, void* d_out, int out_size, void* d_ws, size_t ws_size, hipStream_t stream) {
    static int grid = 0;
    if (grid == 0) {
        if (n_in != 26 || out_size != ML * DM || ws_size < WS_END) { fprintf(stderr, "kernel_launch: unexpected shapes (n_in %d out %d ws %zu, need ws >= %zu)\n", n_in, out_size, ws_size, (size_t)WS_END); grid = -1; return; }
        int dev = 0, cus = 0, per_cu = 0;
        if (hipGetDevice(&dev) != hipSuccess || hipDeviceGetAttribute(&cus, hipDeviceAttributeMultiprocessorCount, dev) != hipSuccess) { grid = -1; return; }
        if (hipFuncSetAttribute((const void*)fwd_kernel, hipFuncAttributeMaxDynamicSharedMemorySize, LDS_BYTES) != hipSuccess) { fprintf(stderr, "kernel_launch: hipFuncSetAttribute failed\n"); grid = -1; return; }
        if (hipOccupancyMaxActiveBlocksPerMultiprocessor(&per_cu, (const void*)fwd_kernel, 512, LDS_BYTES) != hipSuccess || per_cu < 1) { fprintf(stderr, "kernel_launch: occupancy query says %d blocks per CU\n", per_cu); }
        (void)hipGetLastError();
        grid = cus;
    }
    if (grid < 0) return;
    (void)hipMemsetAsync((char*)d_ws + WS_CTL, 0, CTL_ZERO_BYTES, stream);
    Args a{};
    for (int i = 0; i < 26; ++i) a.in[i] = (const float*)d_in[i];
    a.out = (float*)d_out; a.ws = (unsigned char*)d_ws;
#if MK_ONE_LAUNCH
    a.ph_lo = 0; a.ph_hi = NPH;
    hipLaunchKernelGGL(fwd_kernel, dim3(grid), dim3(512), LDS_BYTES, stream, a);
#else
    for (int p = 0; p < NPH; ++p) { a.ph_lo = p; a.ph_hi = p + 1; hipLaunchKernelGGL(fwd_kernel, dim3(grid), dim3(512), LDS_BYTES, stream, a); }
#endif
    const hipError_t le = hipPeekAtLastError();
    if (le != hipSuccess) fprintf(stderr, "kernel_launch: launch failed: %s\n", hipGetErrorName(le));
}
```
